# Optimizing an MI355X kernel written in HIP

```python
import jax
import jax.numpy as jnp
from jax import lax
import numpy as np

D_MODEL = 1024
BATCH = 2
SEQ = 16384
DEPTH = 2
DEC_BATCH = 16
DEC_SEQ = 64
PAST_LEN = 2048

CHUNK = 64
Q_BLOCK = 128
HEAD_DIM = 64
N_FOX_HEADS = 8
N_SB_HEADS = 8
N_SWA_HEADS = 16
N_SWA_KV_HEADS = 4
SWA_GROUP = N_SWA_HEADS // N_SWA_KV_HEADS
WINDOW = 128
WINDOW_CHUNKS = WINDOW // CHUNK
BAND = (WINDOW_CHUNKS + 1) * CHUNK
ROPE_THETA = 500000.0
ROPE_DIM = HEAD_DIM // 4
D_FF = ((8 * D_MODEL + 3 * 256 - 1) // (3 * 256)) * 256
PE_DIM = 256
RMS_EPS = 1e-6
FORGET_BIAS_INIT = 3.0
SCALE = HEAD_DIM ** -0.5
N_AB_LAYERS = (DEPTH + 1) // 2
N_C_LAYERS = DEPTH // 2
FOX_W = N_FOX_HEADS * HEAD_DIM
SB_W = N_SB_HEADS * HEAD_DIM
AB_IN_SPLITS = (FOX_W, 2 * FOX_W, 3 * FOX_W, 3 * FOX_W + N_FOX_HEADS,
                3 * FOX_W + N_FOX_HEADS + SB_W, 3 * FOX_W + N_FOX_HEADS + 2 * SB_W)
AB_IN_WIDTH = 3 * FOX_W + N_FOX_HEADS + 3 * SB_W
C_Q_W = N_SWA_HEADS * HEAD_DIM
C_KV_W = N_SWA_KV_HEADS * HEAD_DIM
C_IN_SPLITS = (C_Q_W, C_Q_W + C_KV_W)
C_IN_WIDTH = C_Q_W + 2 * C_KV_W

kernel_name = "fox_stickbreak_swa_sink_streaming_trunk"


def _rmsnorm(x, g):
    xf = x.astype(jnp.float32)
    y = xf * lax.rsqrt(jnp.mean(xf * xf, axis=-1, keepdims=True) + RMS_EPS)
    return (y * g.astype(jnp.float32)).astype(x.dtype)


def _rope_partial(x, pos):
    half = ROPE_DIM // 2
    inv_freq = ROPE_THETA ** (-2.0 * jnp.arange(half, dtype=jnp.float32) / ROPE_DIM)
    ang = pos.astype(jnp.float32)[:, None] * inv_freq[None, :]
    cos = jnp.cos(ang)[None, :, None, :]
    sin = jnp.sin(ang)[None, :, None, :]
    xf = x.astype(jnp.float32)
    x1 = xf[..., :half]
    x2 = xf[..., half:ROPE_DIM]
    out = jnp.concatenate([x1 * cos - x2 * sin, x2 * cos + x1 * sin, xf[..., ROPE_DIM:]], axis=-1)
    return out.astype(x.dtype)


def _fox_attend(q, k, v, cq, ck, qpos, kpos):
    s = jnp.einsum("bqhd,bkhd->bhqk", q, k).astype(jnp.float32) * SCALE
    s = s + jnp.swapaxes(cq, 1, 2)[:, :, :, None] - jnp.swapaxes(ck, 1, 2)[:, :, None, :]
    s = jnp.where(kpos[None, :] <= qpos[:, None], s, -jnp.inf)
    p = jax.nn.softmax(s, axis=-1)
    return jnp.einsum("bhqk,bkhd->bqhd", p.astype(v.dtype), v)


def _sb_attend(q, k, v, qpos, kpos):
    z = jnp.einsum("bqhd,bkhd->bhqk", q, k).astype(jnp.float32) * SCALE
    mask = kpos[None, :] < qpos[:, None]
    log_1m = jnp.where(mask, jax.nn.log_sigmoid(-z), 0.0)
    between = lax.cumsum(log_1m, axis=3, reverse=True) - log_1m
    a = jnp.where(mask, jnp.exp(jax.nn.log_sigmoid(z) + between), 0.0)
    return jnp.einsum("bhqk,bkhd->bqhd", a.astype(v.dtype), v)


def _ab_project(xn, w_in, b_f):
    B, T, _ = xn.shape
    fq, fk, fv, flog, sq, sk, sv = jnp.split(xn @ w_in, AB_IN_SPLITS, axis=-1)
    fox = [t.reshape(B, T, N_FOX_HEADS, HEAD_DIM) for t in (fq, fk, fv)]
    sb = [t.reshape(B, T, N_SB_HEADS, HEAD_DIM) for t in (sq, sk, sv)]
    logf = jax.nn.log_sigmoid((flog + b_f).astype(jnp.float32))
    return fox[0], fox[1], fox[2], logf, sb[0], sb[1], sb[2]


def _ab_merge(fo, so, w_out):
    B, T = fo.shape[:2]
    return jnp.concatenate([fo.reshape(B, T, FOX_W), so.reshape(B, T, SB_W)], axis=-1) @ w_out


def _ab_mixer_prompt(xn, w_in, b_f, w_out):
    fq, fk, fv, logf, sq, sk, sv = _ab_project(xn, w_in, b_f)
    B, S = xn.shape[:2]
    c = jnp.cumsum(logf, axis=1)
    kpos = jnp.arange(S)

    def block(i):
        start = i * Q_BLOCK
        qpos = start + jnp.arange(Q_BLOCK)
        sl = lambda t: lax.dynamic_slice_in_dim(t, start, Q_BLOCK, axis=1)
        return (_fox_attend(sl(fq), fk, fv, sl(c), c, qpos, kpos),
                _sb_attend(sl(sq), sk, sv, qpos, kpos))

    fo, so = lax.map(block, jnp.arange(S // Q_BLOCK))
    fo = jnp.swapaxes(fo, 0, 1).reshape(B, S, N_FOX_HEADS, HEAD_DIM)
    so = jnp.swapaxes(so, 0, 1).reshape(B, S, N_SB_HEADS, HEAD_DIM)
    return _ab_merge(fo, so, w_out), fk, fv, logf, sk, sv


def _ab_mixer_sample(xn, w_in, b_f, w_out, c_fk, c_fv, c_fl, c_sk, c_sv):
    fq, fk, fv, logf, sq, sk, sv = _ab_project(xn, w_in, b_f)
    P, T = c_fk.shape[1], xn.shape[1]
    c = jnp.cumsum(jnp.concatenate([c_fl.astype(jnp.float32), logf], axis=1), axis=1)
    qpos = P + jnp.arange(T)
    kpos = jnp.arange(P + T)
    fo = _fox_attend(fq, jnp.concatenate([c_fk, fk], axis=1), jnp.concatenate([c_fv, fv], axis=1),
                     c[:, P:], c, qpos, kpos)
    so = _sb_attend(sq, jnp.concatenate([c_sk, sk], axis=1), jnp.concatenate([c_sv, sv], axis=1),
                    qpos, kpos)
    return _ab_merge(fo, so, w_out), fk, fv, logf, sk, sv


def _c_project(xn, w_in, pos):
    B, T, _ = xn.shape
    q, k, v = jnp.split(xn @ w_in, C_IN_SPLITS, axis=-1)
    q = _rope_partial(q.reshape(B, T, N_SWA_HEADS, HEAD_DIM), pos)
    k = _rope_partial(k.reshape(B, T, N_SWA_KV_HEADS, HEAD_DIM), pos)
    return q, k, v.reshape(B, T, N_SWA_KV_HEADS, HEAD_DIM)


def _swa_attend(q, k, v, sinks, mask):
    B, N, Q, H, dh = q.shape
    qg = q.reshape(B, N, Q, N_SWA_KV_HEADS, SWA_GROUP, dh)
    s = jnp.einsum("bnqhgd,bnkhd->bnhgqk", qg, k).astype(jnp.float32) * SCALE
    s = jnp.where(mask[None, :, None, None], s, -jnp.inf)
    sink = sinks.astype(jnp.float32).reshape(1, 1, N_SWA_KV_HEADS, SWA_GROUP, 1, 1)
    m = jnp.maximum(jnp.max(s, axis=-1, keepdims=True), sink)
    e = jnp.exp(s - m)
    p = e / (jnp.sum(e, axis=-1, keepdims=True) + jnp.exp(sink - m))
    o = jnp.einsum("bnhgqk,bnkhd->bnqhgd", p.astype(v.dtype), v)
    return o.reshape(B, N, Q, H, dh)


def _band(t, n_chunks):
    B = t.shape[0]
    tp = jnp.pad(t, ((0, 0), (WINDOW, 0), (0, 0), (0, 0)))
    tp = tp.reshape(B, n_chunks + WINDOW_CHUNKS, CHUNK, N_SWA_KV_HEADS, HEAD_DIM)
    return jnp.concatenate([tp[:, j:j + n_chunks] for j in range(WINDOW_CHUNKS + 1)], axis=2)


def _c_mixer_prompt(xn, w_in, sinks, w_out):
    B, S = xn.shape[:2]
    q, k, v = _c_project(xn, w_in, jnp.arange(S))
    nc = S // CHUNK
    kpos = (jnp.arange(nc)[:, None] - WINDOW_CHUNKS) * CHUNK + jnp.arange(BAND)[None, :]
    o = _swa_attend(q.reshape(B, nc, CHUNK, N_SWA_HEADS, HEAD_DIM), _band(k, nc), _band(v, nc),
                    sinks, (kpos >= 0)[:, None, :])
    return o.reshape(B, S, C_Q_W) @ w_out, k[:, S - WINDOW:], v[:, S - WINDOW:]


def _c_mixer_sample(xn, w_in, sinks, w_out, c_k, c_v):
    B, T = xn.shape[:2]
    q, k, v = _c_project(xn, w_in, PAST_LEN + jnp.arange(T))
    k_all = jnp.concatenate([c_k, k], axis=1)
    v_all = jnp.concatenate([c_v, v], axis=1)
    mask = jnp.ones((1, 1, k_all.shape[1]), dtype=bool)
    o = _swa_attend(q[:, None], k_all[:, None], v_all[:, None], sinks, mask)
    return o.reshape(B, T, C_Q_W) @ w_out, k_all[:, -WINDOW:], v_all[:, -WINDOW:]


def _swiglu(h, g, w_gate, w_up, w_down):
    hn = _rmsnorm(h, g)
    return h + (jax.nn.silu(hn @ w_gate) * (hn @ w_up)) @ w_down


def _per_layer_embed(h, p_i, g, w_gate, w_proj):
    gate = jax.nn.sigmoid(_rmsnorm(h, g) @ w_gate)
    return h + (p_i @ w_proj) * gate


def _trunk(x, p, W, caches):
    states = tuple([] for _ in range(7))
    h = x
    for i in range(DEPTH):
        j = i // 2
        hn = _rmsnorm(h, W["norm_mix"][i])
        if i % 2 == 0:
            args = (hn, W["w_ab_in"][j], W["b_fox_f"][j], W["w_ab_out"][j])
            if caches is None:
                out, *new = _ab_mixer_prompt(*args)
            else:
                out, *new = _ab_mixer_sample(*args, *(c[j] for c in caches[:5]))
            for lst, t in zip(states[:5], new):
                lst.append(t)
        else:
            args = (hn, W["w_c_in"][j], W["c_sinks"][j], W["w_c_out"][j])
            if caches is None:
                out, *new = _c_mixer_prompt(*args)
            else:
                out, *new = _c_mixer_sample(*args, caches[5][j], caches[6][j])
            for lst, t in zip(states[5:], new):
                lst.append(t)
        h = h + out
        h = _swiglu(h, W["norm_ffn"][i], W["w_ffn_gate"][i], W["w_ffn_up"][i], W["w_ffn_down"][i])
        h = _per_layer_embed(h, p[i], W["norm_pe"][i], W["w_pe_gate"][i], W["w_pe_proj"][i])
    y = _rmsnorm(h, W["norm_final"])
    return y, tuple(jnp.stack(lst, axis=0) for lst in states)


def setup_inputs(seed: int = 0) -> dict:
    key = jax.random.key(seed)
    ks = jax.random.split(key, 26)
    f32 = jnp.float32

    def nrm(k, shape, scale=1.0):
        return jax.random.normal(k, shape, f32) * scale

    fox_cache = (N_AB_LAYERS, DEC_BATCH, PAST_LEN, N_FOX_HEADS, HEAD_DIM)
    sb_cache = (N_AB_LAYERS, DEC_BATCH, PAST_LEN, N_SB_HEADS, HEAD_DIM)
    swa_cache = (N_C_LAYERS, DEC_BATCH, WINDOW, N_SWA_KV_HEADS, HEAD_DIM)
    return {
        "x_prompt": nrm(ks[0], (BATCH, SEQ, D_MODEL)),
        "x_sample": nrm(ks[1], (DEC_BATCH, DEC_SEQ, D_MODEL)),
        "cache_fox_k": nrm(ks[2], fox_cache),
        "cache_fox_v": nrm(ks[3], fox_cache),
        "cache_fox_logf": jax.nn.log_sigmoid(FORGET_BIAS_INIT + nrm(ks[4], fox_cache[:4])),
        "cache_sb_k": nrm(ks[5], sb_cache),
        "cache_sb_v": nrm(ks[6], sb_cache),
        "cache_swa_k": nrm(ks[7], swa_cache),
        "cache_swa_v": nrm(ks[8], swa_cache),
        "p_prompt": nrm(ks[9], (DEPTH, BATCH, SEQ, PE_DIM)),
        "p_sample": nrm(ks[10], (DEPTH, DEC_BATCH, DEC_SEQ, PE_DIM)),
        "norm_mix": 1.0 + nrm(ks[11], (DEPTH, D_MODEL), 0.05),
        "w_ab_in": nrm(ks[12], (N_AB_LAYERS, D_MODEL, AB_IN_WIDTH), D_MODEL ** -0.5),
        "b_fox_f": FORGET_BIAS_INIT + nrm(ks[13], (N_AB_LAYERS, N_FOX_HEADS), 0.1),
        "w_ab_out": nrm(ks[14], (N_AB_LAYERS, FOX_W + SB_W, D_MODEL), (FOX_W + SB_W) ** -0.5),
        "w_c_in": nrm(ks[15], (N_C_LAYERS, D_MODEL, C_IN_WIDTH), D_MODEL ** -0.5),
        "c_sinks": nrm(ks[16], (N_C_LAYERS, N_SWA_HEADS), 0.5),
        "w_c_out": nrm(ks[17], (N_C_LAYERS, C_Q_W, D_MODEL), C_Q_W ** -0.5),
        "norm_ffn": 1.0 + nrm(ks[18], (DEPTH, D_MODEL), 0.05),
        "w_ffn_gate": nrm(ks[19], (DEPTH, D_MODEL, D_FF), D_MODEL ** -0.5),
        "w_ffn_up": nrm(ks[20], (DEPTH, D_MODEL, D_FF), D_MODEL ** -0.5),
        "w_ffn_down": nrm(ks[21], (DEPTH, D_FF, D_MODEL), D_FF ** -0.5),
        "norm_pe": 1.0 + nrm(ks[22], (DEPTH, D_MODEL), 0.05),
        "w_pe_gate": nrm(ks[23], (DEPTH, D_MODEL, D_MODEL), D_MODEL ** -0.5),
        "w_pe_proj": nrm(ks[24], (DEPTH, PE_DIM, D_MODEL), PE_DIM ** -0.5),
        "norm_final": 1.0 + nrm(ks[25], (D_MODEL,), 0.05),
    }


def reference(x_prompt, x_sample, cache_fox_k, cache_fox_v, cache_fox_logf, cache_sb_k, cache_sb_v,
              cache_swa_k, cache_swa_v, p_prompt, p_sample, norm_mix, w_ab_in, b_fox_f, w_ab_out,
              w_c_in, c_sinks, w_c_out, norm_ffn, w_ffn_gate, w_ffn_up, w_ffn_down, norm_pe,
              w_pe_gate, w_pe_proj, norm_final):
    W = {
        "norm_mix": norm_mix, "w_ab_in": w_ab_in, "b_fox_f": b_fox_f, "w_ab_out": w_ab_out,
        "w_c_in": w_c_in, "c_sinks": c_sinks, "w_c_out": w_c_out,
        "norm_ffn": norm_ffn, "w_ffn_gate": w_ffn_gate, "w_ffn_up": w_ffn_up, "w_ffn_down": w_ffn_down,
        "norm_pe": norm_pe, "w_pe_gate": w_pe_gate, "w_pe_proj": w_pe_proj, "norm_final": norm_final,
    }
    caches = (cache_fox_k, cache_fox_v, cache_fox_logf, cache_sb_k, cache_sb_v, cache_swa_k, cache_swa_v)
    y_prompt, (pf_k, pf_v, pf_lf, ps_k, ps_v, pw_k, pw_v) = _trunk(x_prompt, p_prompt, W, None)
    y_sample, (sf_k, sf_v, sf_lf, ss_k, ss_v, sw_k, sw_v) = _trunk(x_sample, p_sample, W, caches)
    return (y_prompt, y_sample, pf_k, pf_v, pf_lf, ps_k, ps_v, pw_k, pw_v,
            sf_k, sf_v, sf_lf, ss_k, ss_v, sw_k, sw_v)
```

```cpp
#include <hip/hip_runtime.h>
#include <hip/hip_cooperative_groups.h>
#include <cstdio>
#include <cstdint>
namespace cg = cooperative_groups;

#ifndef MULTI_LAUNCH
#define MULTI_LAUNCH 0
#endif

typedef unsigned short bf16_t;
typedef short bf16x8 __attribute__((ext_vector_type(8)));
typedef float f32x16 __attribute__((ext_vector_type(16)));
typedef float f32x4 __attribute__((ext_vector_type(4)));
typedef float f32x2 __attribute__((ext_vector_type(2)));
typedef unsigned u32x4 __attribute__((ext_vector_type(4)));
typedef unsigned u32x2 __attribute__((ext_vector_type(2)));
typedef __bf16 bf16x2_t __attribute__((ext_vector_type(2)));
#define DI __device__ __forceinline__

constexpr int S = 16384, MP = 32768, MS = 1024, M = MP + MS, D = 1024, DFF = 2816, PAST = 2048, TS = PAST + 64, PE = 256;
constexpr int NTHR = 512, NW = 8;
constexpr float EPS = 1e-6f, LOG2E = 1.4426950408889634f, QS = 0.125f * 1.4426950408889634f, NEGBIG = -1e30f;

constexpr size_t O_Y = 0;
constexpr size_t O_PF_K = (size_t)M * D;
constexpr size_t O_PF_V = O_PF_K + (size_t)MP * 512;
constexpr size_t O_PF_LF = O_PF_V + (size_t)MP * 512;
constexpr size_t O_PS_K = O_PF_LF + (size_t)MP * 8;
constexpr size_t O_PS_V = O_PS_K + (size_t)MP * 512;
constexpr size_t O_PW_K = O_PS_V + (size_t)MP * 512;
constexpr size_t O_PW_V = O_PW_K + 2 * 128 * 256;
constexpr size_t O_SF_K = O_PW_V + 2 * 128 * 256;
constexpr size_t O_SF_V = O_SF_K + (size_t)MS * 512;
constexpr size_t O_SF_LF = O_SF_V + (size_t)MS * 512;
constexpr size_t O_SS_K = O_SF_LF + (size_t)MS * 8;
constexpr size_t O_SS_V = O_SS_K + (size_t)MS * 512;
constexpr size_t O_SW_K = O_SS_V + (size_t)MS * 512;
constexpr size_t O_SW_V = O_SW_K + 16 * 128 * 256;
constexpr size_t O_END = O_SW_V + 16 * 128 * 256;

constexpr size_t al256(size_t x) { return (x + 255) & ~(size_t)255; }
constexpr size_t W_AB_IN = 0;
constexpr size_t W_AB_OUT = W_AB_IN + (size_t)3072 * 1024 * 2;
constexpr size_t W_C_IN = W_AB_OUT + (size_t)1024 * 1024 * 2;
constexpr size_t W_C_OUT = W_C_IN + (size_t)1536 * 1024 * 2;
constexpr size_t W_GU = W_C_OUT + (size_t)1024 * 1024 * 2;
constexpr size_t W_DN = W_GU + (size_t)2 * 5632 * 1024 * 2;
constexpr size_t W_PG = W_DN + (size_t)2 * 1024 * 2816 * 2;
constexpr size_t W_PP = W_PG + (size_t)2 * 1024 * 1024 * 2;
constexpr size_t WS_SSQ = W_PP + (size_t)2 * 1024 * 256 * 2;
constexpr size_t WS_ROPE = al256(WS_SSQ + (size_t)7 * M * 4);
constexpr size_t WS_C2P = WS_ROPE + (size_t)16384 * 16 * 4;
constexpr size_t WS_C2S = WS_C2P + (size_t)16 * 16384 * 4;
constexpr size_t WS_LOGF = WS_C2S + (size_t)128 * TS * 4;
constexpr size_t WS_KMAX = al256(WS_LOGF + (size_t)M * 8 * 4);
constexpr size_t WS_BAR = WS_KMAX + 1024;
constexpr size_t WS_K1S = WS_BAR + 16384;
constexpr size_t WS_VT1S = WS_K1S + (size_t)16 * 192 * 256 * 2;
constexpr size_t WS_HB0 = al256(WS_VT1S + (size_t)16 * 4 * 64 * 192 * 2);
constexpr size_t WS_HB1 = WS_HB0 + (size_t)M * 1024 * 2;
constexpr size_t WS_R = WS_HB1 + (size_t)M * 1024 * 2;
constexpr size_t WS_Q = WS_R;
constexpr size_t WS_KP = WS_Q + (size_t)M * 1024 * 2;
constexpr size_t WS_KS = WS_KP + (size_t)MP * 1024 * 2;
constexpr size_t WS_VTP = WS_KS + (size_t)16 * TS * 1024 * 2;
constexpr size_t WS_PB = WS_VTP + (size_t)2 * 2 * 8 * 64 * 16384 * 2;
constexpr size_t WS_END = WS_PB + (size_t)2 * M * 256 * 2;
constexpr size_t WS_ACT = WS_R;
constexpr size_t WS_VTS = WS_HB0;
constexpr size_t WS_K1P = WS_VTP;
constexpr size_t WS_VT1P = WS_VTP + (size_t)MP * 256 * 2;
static_assert((size_t)M * DFF * 2 <= WS_VTP - WS_R, "ACT overlay");
static_assert((size_t)2 * 16 * 8 * 64 * TS * 2 <= (size_t)M * 1024 * 2, "VTS overlay");

struct Params {
    const float* in[26];
    float* out;
    unsigned char* ws;
    int ph_lo, ph_hi;
};

DI unsigned cvtpk(float lo, float hi) { f32x2 v = {lo, hi}; bf16x2_t b = __builtin_convertvector(v, bf16x2_t); return __builtin_bit_cast(unsigned, b); }
DI float wave_sum(float v) {
#pragma unroll
    for (int o = 1; o < 64; o <<= 1) v += __shfl_xor(v, o);
    return v;
}
DI int crow(int r, int hi) { return (r & 3) + 8 * (r >> 2) + 4 * hi; }
DI int permkv(int kv) { return (kv & 0x33) | ((kv & 8) >> 1) | ((kv & 4) << 1); }
DI f32x16 mfma32(bf16x8 a, bf16x8 b, f32x16 c) { return __builtin_amdgcn_mfma_f32_32x32x16_bf16(a, b, c, 0, 0, 0); }
DI float max3f(float a, float b, float c) { float r; asm("v_max3_f32 %0, %1, %2, %3" : "=v"(r) : "v"(a), "v"(b), "v"(c)); return r; }
DI float fast_exp2(float x) { return __builtin_amdgcn_exp2f(x); }
DI float fast_rcp(float x) { return __builtin_amdgcn_rcpf(x); }

constexpr int PITCH = 144;
constexpr int GSTG = 512 * 128;
constexpr int LDS_BYTES = 2 * GSTG;
constexpr int ASTG = 2 * 64 * PITCH + 256;

template <int MAP>
DI void wtrans(const float* W, const float* W2, int K, int Nsrc, bf16_t* Wt, int Ndst, const float* g, float* scr) {
    const int tid = threadIdx.x;
    const int ntn = Ndst / 64, ntiles = (K / 64) * ntn;
    for (int t0 = 2 * (int)blockIdx.x; t0 < ntiles; t0 += 2 * (int)gridDim.x) {
        float v[2][8];
#pragma unroll
        for (int q = 0; q < 2; ++q) {
            const int tile = t0 + q;
            if (tile < ntiles) {
                const int n0 = (tile % ntn) * 64, k0 = (tile / ntn) * 64; const int np = n0 + (tid & 63);
                const float* src = W; int col = np;
                if (MAP == 1) { col = np < 1536 ? np : np + 8; }
                if (MAP == 2) { const int blk = np >> 5; col = (blk >> 1) * 32 + (np & 31); src = (blk & 1) ? W2 : W; }
#pragma unroll
                for (int i = 0; i < 8; ++i) { const int k = i * 8 + (tid >> 6); v[q][i] = src[(size_t)(k0 + k) * Nsrc + col]; if (g) v[q][i] *= g[k0 + k]; }
            }
        }
#pragma unroll
        for (int q = 0; q < 2; ++q)
#pragma unroll
            for (int i = 0; i < 8; ++i) scr[q * 4160 + (i * 8 + (tid >> 6)) * 65 + (tid & 63)] = v[q][i];
        __syncthreads();
#pragma unroll
        for (int q = 0; q < 2; ++q) {
            const int tile = t0 + q;
            if (tile < ntiles) {
                const int n0 = (tile % ntn) * 64, k0 = (tile / ntn) * 64;
                const int nn = tid >> 3, kc = (tid & 7) * 8;
                unsigned w[4];
#pragma unroll
                for (int j = 0; j < 4; ++j) w[j] = cvtpk(scr[q * 4160 + (kc + 2 * j) * 65 + nn], scr[q * 4160 + (kc + 2 * j + 1) * 65 + nn]);
                *(u32x4*)(Wt + (size_t)(n0 + nn) * K + k0 + kc) = (u32x4){w[0], w[1], w[2], w[3]};
            }
        }
        __syncthreads();
    }
}

DI void vtrans(const float* src, int nb, int Tc, int H, bf16_t* dst, int ldv, float* scr) {
    const int tid = threadIdx.x;
    const int ntb = Tc / 64, units = nb * H * ntb;
    for (int u0 = 2 * (int)blockIdx.x; u0 < units; u0 += 2 * (int)gridDim.x) {
        float v[2][8];
#pragma unroll
        for (int q = 0; q < 2; ++q) {
            const int u = u0 + q;
            if (u < units) {
                const int tb = u % ntb, bh = u / ntb, h = bh % H, b = bh / H;
#pragma unroll
                for (int i = 0; i < 8; ++i) { const int t = i * 8 + (tid >> 6), d = tid & 63; v[q][i] = src[((size_t)(b * Tc + tb * 64 + t) * H + h) * 64 + d]; }
            }
        }
#pragma unroll
        for (int q = 0; q < 2; ++q)
#pragma unroll
            for (int i = 0; i < 8; ++i) scr[q * 4160 + (i * 8 + (tid >> 6)) * 65 + (tid & 63)] = v[q][i];
        __syncthreads();
#pragma unroll
        for (int q = 0; q < 2; ++q) {
            const int u = u0 + q;
            if (u < units) {
                const int tb = u % ntb, bh = u / ntb, h = bh % H, b = bh / H;
                const int d = tid >> 3, qq = tid & 7;
                unsigned w[4];
#pragma unroll
                for (int j = 0; j < 4; ++j) {
                    const int p0 = 8 * qq + 2 * j, p1 = p0 + 1;
                    w[j] = cvtpk(scr[q * 4160 + permkv(p0) * 65 + d], scr[q * 4160 + permkv(p1) * 65 + d]);
                }
                *(u32x4*)(dst + ((size_t)(b * H + h) * 64 + d) * ldv + tb * 64 + 8 * qq) = (u32x4){w[0], w[1], w[2], w[3]};
            }
        }
        __syncthreads();
    }
}

DI void phase_prep(const Params& p, char* lds) {
    float* scr = (float*)lds;
    unsigned char* ws = p.ws;
    const int tid = threadIdx.x, lane = tid & 63, wave = tid >> 6;
    const size_t gtid = (size_t)blockIdx.x * NTHR + tid, gthreads = (size_t)gridDim.x * NTHR;
    wtrans<1>(p.in[12], nullptr, 1024, 3080, (bf16_t*)(ws + W_AB_IN), 3072, p.in[11], scr);
    wtrans<0>(p.in[14], nullptr, 1024, 1024, (bf16_t*)(ws + W_AB_OUT), 1024, nullptr, scr);
    wtrans<0>(p.in[15], nullptr, 1024, 1536, (bf16_t*)(ws + W_C_IN), 1536, p.in[11] + 1024, scr);
    wtrans<0>(p.in[17], nullptr, 1024, 1024, (bf16_t*)(ws + W_C_OUT), 1024, nullptr, scr);
    for (int l = 0; l < 2; ++l) {
        wtrans<2>(p.in[19] + (size_t)l * 1024 * DFF, p.in[20] + (size_t)l * 1024 * DFF, 1024, DFF, (bf16_t*)(ws + W_GU) + (size_t)l * 5632 * 1024, 5632, p.in[18] + l * 1024, scr);
        wtrans<0>(p.in[21] + (size_t)l * DFF * 1024, nullptr, DFF, 1024, (bf16_t*)(ws + W_DN) + (size_t)l * 1024 * DFF, 1024, nullptr, scr);
        wtrans<0>(p.in[23] + (size_t)l * 1024 * 1024, nullptr, 1024, 1024, (bf16_t*)(ws + W_PG) + (size_t)l * 1024 * 1024, 1024, p.in[22] + l * 1024, scr);
        wtrans<0>(p.in[24] + (size_t)l * 256 * 1024, nullptr, 256, 1024, (bf16_t*)(ws + W_PP) + (size_t)l * 1024 * 256, 1024, nullptr, scr);
    }
    vtrans(p.in[8], 16, 128, 4, (bf16_t*)(ws + WS_VT1S), 192, scr);
    {
        bf16_t* K1s = (bf16_t*)(ws + WS_K1S);
        const size_t n1 = (size_t)16 * 128 * 32;
        for (size_t u = gtid; u < n1; u += gthreads) {
            const int c8 = (int)(u & 31); const int t = (int)((u >> 5) & 127), b = (int)(u >> 12);
            const float* s = p.in[7] + ((size_t)(b * 128 + t) * 256 + c8 * 8);
            const f32x4 x = *(const f32x4*)s, y = *(const f32x4*)(s + 4);
            *(u32x4*)(K1s + ((size_t)(b * 192 + t) * 256 + c8 * 8)) = (u32x4){cvtpk(x[0], x[1]), cvtpk(x[2], x[3]), cvtpk(y[0], y[1]), cvtpk(y[2], y[3])};
        }
        const size_t n2 = (size_t)2 * 16 * 64 * 64;
        for (size_t u = gtid; u < n2; u += gthreads) {
            const int c4 = (int)(u & 63); const int t = (int)((u >> 6) & 63), b = (int)((u >> 12) & 15), kv = (int)(u >> 16);
            const float* s = (kv ? p.in[8] : p.in[7]) + ((size_t)(b * 128 + 64 + t) * 256 + c4 * 4);
            float* o = p.out + (kv ? O_SW_V : O_SW_K) + ((size_t)(b * 128 + t) * 256 + c4 * 4);
            *(f32x4*)o = *(const f32x4*)s;
        }
    }
    {
        bf16_t* pb = (bf16_t*)(ws + WS_PB);
        const size_t n = (size_t)2 * M * 32;
        for (size_t u0 = gtid; u0 < n; u0 += 4 * gthreads) {
            f32x4 x[4], y[4];
#pragma unroll
            for (int k = 0; k < 4; ++k) {
                const size_t u = u0 + k * gthreads;
                if (u < n) {
                    const int c8 = (int)(u & 31); const size_t lr = u >> 5; const int l = (int)(lr / M), r = (int)(lr % M);
                    const float* s = (r < MP ? p.in[9] + ((size_t)l * MP + r) * PE : p.in[10] + ((size_t)l * MS + (r - MP)) * PE) + c8 * 8;
                    x[k] = *(const f32x4*)s; y[k] = *(const f32x4*)(s + 4);
                }
            }
#pragma unroll
            for (int k = 0; k < 4; ++k) {
                const size_t u = u0 + k * gthreads;
                if (u < n) *(u32x4*)(pb + (u >> 5) * PE + (u & 31) * 8) = (u32x4){cvtpk(x[k][0], x[k][1]), cvtpk(x[k][2], x[k][3]), cvtpk(y[k][0], y[k][1]), cvtpk(y[k][2], y[k][3])};
            }
        }
    }
    {
        float* rope = (float*)(ws + WS_ROPE);
        for (size_t u = gtid; u < (size_t)16384 * 8; u += gthreads) {
            const int i = (int)(u & 7); const int pos = (int)(u >> 3);
            const double inv = pow(500000.0, -(double)i / 8.0), ang = (double)pos * inv;
            rope[2 * u] = (float)cos(ang); rope[2 * u + 1] = (float)sin(ang);
        }
        float* ssq = (float*)(ws + WS_SSQ);
        for (size_t u = gtid; u < (size_t)6 * M; u += gthreads) ssq[M + u] = 0.f;
    }
    {
        __syncthreads();
        const float* wab = p.in[12]; const float* g0 = p.in[11];
        for (int u = tid; u < 8 * 1024; u += NTHR) { const int h = u >> 10, k = u & 1023; scr[u] = g0[k] * wab[(size_t)k * 3080 + 1536 + h]; }
        __syncthreads();
        bf16_t* xb = (bf16_t*)(ws + WS_HB1);
        float* ssq0 = (float*)(ws + WS_SSQ);
        float* logf = (float*)(ws + WS_LOGF);
        const float* bf = p.in[13];
        const int rstep = gridDim.x * NW;
        for (int row0 = blockIdx.x * NW + wave; row0 < M; row0 += 2 * rstep) {
            f32x4 vv[2][4];
#pragma unroll
            for (int q = 0; q < 2; ++q) {
                const int row = row0 + q * rstep;
                if (row < M) {
                    const float* xr = row < MP ? p.in[0] + (size_t)row * D : p.in[1] + (size_t)(row - MP) * D;
#pragma unroll
                    for (int j = 0; j < 4; ++j) vv[q][j] = *(const f32x4*)(xr + 256 * j + 4 * lane);
                }
            }
#pragma unroll
            for (int q = 0; q < 2; ++q) {
                const int row = row0 + q * rstep;
                if (row >= M) break;
                f32x4 v[4]; float ss = 0.f;
#pragma unroll
                for (int j = 0; j < 4; ++j) { v[j] = vv[q][j]; ss += (v[j][0] * v[j][0] + v[j][1] * v[j][1]) + (v[j][2] * v[j][2] + v[j][3] * v[j][3]); }
                ss = wave_sum(ss);
#pragma unroll
                for (int j = 0; j < 4; ++j) *(u32x2*)(xb + (size_t)row * D + 256 * j + 4 * lane) = (u32x2){cvtpk(v[j][0], v[j][1]), cvtpk(v[j][2], v[j][3])};
                const float rstd = 1.0f / sqrtf(ss * (1.0f / D) + EPS);
                float mine = 0.f;
#pragma unroll
                for (int h = 0; h < 8; ++h) {
                    float d = 0.f;
#pragma unroll
                    for (int j = 0; j < 4; ++j) { const f32x4 w = *(const f32x4*)(scr + h * 1024 + 256 * j + 4 * lane); d += (v[j][0] * w[0] + v[j][1] * w[1]) + (v[j][2] * w[2] + v[j][3] * w[3]); }
                    d = wave_sum(d);
                    if (lane == h) mine = d;
                }
                if (lane == 0) ssq0[row] = ss;
                if (lane < 8) {
                    const float x = mine * rstd + bf[lane];
                    const float lf = fminf(x, 0.f) - log1pf(expf(-fabsf(x)));
                    logf[(size_t)row * 8 + lane] = lf;
                    if (row < MP) p.out[O_PF_LF + (size_t)row * 8 + lane] = lf; else p.out[O_SF_LF + (size_t)(row - MP) * 8 + lane] = lf;
                }
            }
        }
        __syncthreads();
    }
}

DI void kmax_items(const Params& p, char* lds, int first, int stride) {
    float* sc = (float*)lds;
    const int tid = threadIdx.x, lane = tid & 63, wave = tid >> 6;
    for (int it = first; it < 128; it += stride) {
        const int b = it >> 3, h = it & 7;
        float mx = 0.f;
        for (int t = tid; t < PAST; t += NTHR) {
            const f32x4* r = (const f32x4*)(p.in[2] + ((size_t)(b * PAST + t) * 8 + h) * 64);
            float ss = 0.f;
#pragma unroll
            for (int c = 0; c < 16; ++c) { const f32x4 w = r[c]; ss += (w[0] * w[0] + w[1] * w[1]) + (w[2] * w[2] + w[3] * w[3]); }
            mx = fmaxf(mx, ss);
        }
#pragma unroll
        for (int o = 1; o < 64; o <<= 1) mx = fmaxf(mx, __shfl_xor(mx, o));
        __syncthreads();
        if (lane == 0) sc[wave] = mx;
        __syncthreads();
        if (tid == 0) { float m = sc[0];
#pragma unroll
            for (int w = 1; w < NW; ++w) m = fmaxf(m, sc[w]);
            atomicMax((unsigned*)(p.ws + WS_KMAX) + 16 + it, __float_as_uint(m)); }
    }
    __syncthreads();
}

DI void cumsum_items(const Params& p, char* lds, int first, int stride) {
    float* sc = (float*)lds;
    const int tid = threadIdx.x;
    const float* logf = (const float*)(p.ws + WS_LOGF);
    for (int it = first; it < 16 + 128; it += stride) {
        int T, per; float* dst;
        const bool pr = it < 16;
        int b, h;
        if (pr) { b = it >> 3; h = it & 7; T = S; per = S / NTHR; dst = (float*)(p.ws + WS_C2P) + (size_t)it * S; }
        else { const int j = it - 16; b = j >> 3; h = j & 7; T = TS; per = (TS + NTHR - 1) / NTHR; dst = (float*)(p.ws + WS_C2S) + (size_t)j * TS; }
        const int t0 = tid * per, t1 = min(T, t0 + per);
        auto ld = [&](int t) -> float {
            if (pr) return logf[((size_t)(b * S + t)) * 8 + h];
            if (t < PAST) return p.in[4][((size_t)(b * PAST + t)) * 8 + h];
            return logf[((size_t)(MP + b * 64 + (t - PAST))) * 8 + h];
        };
        float s = 0.f;
        for (int t = t0; t < t1; ++t) s += ld(t);
        __syncthreads();
        sc[tid] = s;
        __syncthreads();
        for (int o = 1; o < NTHR; o <<= 1) {
            const float a = (tid >= o) ? sc[tid - o] : 0.f;
            __syncthreads();
            sc[tid] += a;
            __syncthreads();
        }
        float run = (tid > 0) ? sc[tid - 1] : 0.f;
        for (int t = t0; t < t1; ++t) { run += ld(t); dst[t] = run * LOG2E; }
        __syncthreads();
    }
}

template <int MI>
DI void gemm_mainloop(f32x16 (&acc)[MI][2], const bf16_t* Aptr, int lda, const bf16_t* Bt, int ldb, int K, char* lds, u32x4 (&ra)[MI], u32x4 (&rb)[4],
                      bool chained_in, const bf16_t* An, const bf16_t* Bn, bool has_next) {
    const int tid = threadIdx.x, lane = tid & 63, wave = tid >> 6, wm = wave >> 2, wn = wave & 3, l32 = lane & 31, hi = lane >> 5;
    const int r0 = tid >> 3, c8 = tid & 7;
    const int nt = K / 64;
    const int woff = r0 * 128 + ((c8 ^ ((r0 >> 1) & 7)) * 16);
#define G_LOAD(kt) do { const bf16_t* ap_ = ((kt) < nt) ? Aptr + (kt) * 64 : An + ((kt) - nt) * 64; const bf16_t* bp_ = ((kt) < nt) ? Bt + (kt) * 64 : Bn + ((kt) - nt) * 64; \
        _Pragma("unroll") for (int i = 0; i < MI; ++i) ra[i] = *(const u32x4*)(ap_ + (size_t)(r0 + 64 * i) * lda + c8 * 8); \
        _Pragma("unroll") for (int i = 0; i < 4; ++i) rb[i] = *(const u32x4*)(bp_ + (size_t)(r0 + 64 * i) * ldb + c8 * 8); } while (0)
#define G_LOAD_A(kt) do { const bf16_t* ap_ = ((kt) < nt) ? Aptr + (kt) * 64 : An + ((kt) - nt) * 64; \
        _Pragma("unroll") for (int i = 0; i < MI; ++i) ra[i] = *(const u32x4*)(ap_ + (size_t)(r0 + 64 * i) * lda + c8 * 8); } while (0)
#define G_LOAD_B(kt) do { const bf16_t* bp_ = ((kt) < nt) ? Bt + (kt) * 64 : Bn + ((kt) - nt) * 64; \
        _Pragma("unroll") for (int i = 0; i < 4; ++i) rb[i] = *(const u32x4*)(bp_ + (size_t)(r0 + 64 * i) * ldb + c8 * 8); } while (0)
#define G_STORE_A(buf) do { _Pragma("unroll") for (int i = 0; i < MI; ++i) *(u32x4*)(lds + (buf) * GSTG + i * 8192 + woff) = ra[i]; } while (0)
#define G_STORE_B(buf) do { _Pragma("unroll") for (int i = 0; i < 4; ++i) *(u32x4*)(lds + (buf) * GSTG + 32768 + i * 8192 + woff) = rb[i]; } while (0)
#define G_RD(f, s) do { fb[f][0] = *(const bf16x8*)(Bs + offs[s]); fb[f][1] = *(const bf16x8*)(Bs + 32 * 128 + offs[s]); \
        _Pragma("unroll") for (int mi = 0; mi < MI; ++mi) fa[f][mi] = *(const bf16x8*)(As + mi * 32 * 128 + offs[s]); } while (0)
#define G_MMA(f) do { _Pragma("unroll") for (int mi = 0; mi < MI; ++mi) { \
            acc[mi][0] = mfma32(fb[f][0], fa[f][mi], acc[mi][0]); acc[mi][1] = mfma32(fb[f][1], fa[f][mi], acc[mi][1]); } } while (0)
#define G_FENCE() __builtin_amdgcn_sched_barrier(0)
    if (!chained_in) { G_LOAD(0); G_STORE_A(0); G_STORE_B(0); G_LOAD(1); __syncthreads(); }
    const int rsw = (l32 >> 1) & 7;
    int offs[4];
#pragma unroll
    for (int s = 0; s < 4; ++s) offs[s] = l32 * 128 + (((2 * s + hi) ^ rsw) * 16);
    bf16x8 fa[2][MI], fb[2][2];
    for (int t = 0; t < nt; ++t) {
        const char* As = lds + (t & 1) * GSTG + (wm * 32 * MI) * 128;
        const char* Bs = lds + (t & 1) * GSTG + 32768 + (wn * 64) * 128;
        const bool st = (t + 1 < nt) || has_next, ld = (t + 2 < nt) || has_next;
        G_RD(0, 0); G_RD(1, 1);
        G_FENCE();
        G_MMA(0);
        G_FENCE();
        if (st) G_STORE_A((t + 1) & 1);
        if (MI == 3 && ld) G_LOAD_A(t + 2);
        G_RD(0, 2);
        G_FENCE();
        G_MMA(1);
        G_FENCE();
        if (st) G_STORE_B((t + 1) & 1);
        if (MI != 3 && ld) G_LOAD_A(t + 2);
        if (ld) G_LOAD_B(t + 2);
        G_RD(1, 3);
        G_FENCE();
        G_MMA(0);
        G_FENCE();
        G_MMA(1);
        G_FENCE();
        __syncthreads();
    }
#undef G_RD
#undef G_FENCE
#undef G_STORE_A
#undef G_STORE_B
#undef G_MMA
#undef G_LOAD
#undef G_LOAD_A
#undef G_LOAD_B
}

template <int MI>
DI void gemm_preload(u32x4 (&ra)[MI], u32x4 (&rb)[4], const bf16_t* Aptr, int lda, const bf16_t* Bt, int ldb) {
    const int r0 = threadIdx.x >> 3, c8 = threadIdx.x & 7;
#pragma unroll
    for (int i = 0; i < MI; ++i) ra[i] = *(const u32x4*)(Aptr + (size_t)(r0 + 64 * i) * lda + c8 * 8);
#pragma unroll
    for (int i = 0; i < 4; ++i) rb[i] = *(const u32x4*)(Bt + (size_t)(r0 + 64 * i) * ldb + c8 * 8);
}

template <int MI>
DI void zero_acc(f32x16 (&acc)[MI][2]) {
#pragma unroll
    for (int a = 0; a < MI; ++a)
#pragma unroll
        for (int b = 0; b < 2; ++b)
#pragma unroll
            for (int r = 0; r < 16; ++r) acc[a][b][r] = 0.f;
}

DI float rstd_of(const float* ssq, int row) { return 1.0f / sqrtf(ssq[row] * (1.0f / D) + EPS); }

template <int MI>
DI void store_resid(const f32x16 (&acc)[MI][2], int m0, int n0, float* H, bf16_t* hb, float* ssq_out) {
    const int tid = threadIdx.x, lane = tid & 63, wave = tid >> 6, wm = wave >> 2, wn = wave & 3, l32 = lane & 31, hi = lane >> 5;
#pragma unroll
    for (int mi = 0; mi < MI; ++mi) {
        const int row = m0 + 32 * MI * wm + 32 * mi + l32;
        float ss = 0.f;
#pragma unroll
        for (int ni = 0; ni < 2; ++ni)
#pragma unroll
            for (int g4 = 0; g4 < 4; ++g4) {
                const int col = n0 + 64 * wn + 32 * ni + 8 * g4 + 4 * hi;
                const f32x4 v = {acc[mi][ni][4 * g4], acc[mi][ni][4 * g4 + 1], acc[mi][ni][4 * g4 + 2], acc[mi][ni][4 * g4 + 3]};
                *(f32x4*)(H + (size_t)row * D + col) = v;
                if (hb) *(u32x2*)(hb + (size_t)row * D + col) = (u32x2){cvtpk(v[0], v[1]), cvtpk(v[2], v[3])};
                ss += (v[0] * v[0] + v[1] * v[1]) + (v[2] * v[2] + v[3] * v[3]);
            }
        ss += __shfl_xor(ss, 32);
        if (hi == 0) atomicAdd(ssq_out + row, ss);
    }
}

enum { E_INPROJ0 = 1, E_OUT = 3, E_GU = 4, E_DOWN = 5, E_PE = 6, E_INPROJ1 = 7 };

template <int EPI, int MI>
DI void gemm_phase(const Params& p, int layer, char* lds) {
    unsigned char* ws = p.ws;
    const int tid = threadIdx.x, lane = tid & 63, wave = tid >> 6, wm = wave >> 2, wn = wave & 3, l32 = lane & 31, hi = lane >> 5;
    constexpr int BM = 64 * MI, WR = 32 * MI;
    float* H = p.out;
    float* ssq = (float*)(ws + WS_SSQ);
    bf16_t* hb0 = (bf16_t*)(ws + WS_HB0); bf16_t* hb1 = (bf16_t*)(ws + WS_HB1);
    int N, K; const bf16_t* A; const bf16_t* Bt;
    if (EPI == E_INPROJ0) { N = 3072; K = 1024; A = hb1; Bt = (const bf16_t*)(ws + W_AB_IN); }
    if (EPI == E_OUT) { N = 1024; K = 1024; A = (const bf16_t*)(ws + WS_Q); Bt = (const bf16_t*)(ws + (layer ? W_C_OUT : W_AB_OUT)); }
    if (EPI == E_GU) { N = 5632; K = 1024; A = layer ? hb1 : hb0; Bt = (const bf16_t*)(ws + W_GU) + (size_t)layer * 5632 * 1024; }
    if (EPI == E_DOWN) { N = 1024; K = DFF; A = (const bf16_t*)(ws + WS_ACT); Bt = (const bf16_t*)(ws + W_DN) + (size_t)layer * 1024 * DFF; }
    if (EPI == E_PE) { N = 1024; K = 1024; A = layer ? hb0 : hb1; Bt = (const bf16_t*)(ws + W_PG) + (size_t)layer * 1024 * 1024; }
    if (EPI == E_INPROJ1) { N = 1536; K = 1024; A = hb0; Bt = (const bf16_t*)(ws + W_C_IN); }
    const int ntn = N / 256, MT = M / BM, Gd = gridDim.x;
    const int nx = (Gd % 8 == 0) ? 8 : 1, xcd = (nx == 8) ? (int)(blockIdx.x & 7) : 0, local = (nx == 8) ? (int)(blockIdx.x >> 3) : (int)blockIdx.x, nl = Gd / nx;
    const int m_lo = (xcd * MT) / nx, mtx = ((xcd + 1) * MT) / nx - m_lo;
    const int GM = (ntn >= 8) ? 4 : 8;
    u32x4 ra[MI], rb[4];
    int m0 = 0, n0 = 0;
#define TILE_MN(jj, mm, nn) do { const int g_ = (jj) / (GM * ntn), within_ = (jj) - g_ * GM * ntn, fm_ = g_ * GM, gsz_ = min(GM, mtx - fm_); \
        mm = (m_lo + fm_ + within_ % gsz_) * BM; nn = (within_ / gsz_) * 256; } while (0)
    if (local < mtx * ntn) TILE_MN(local, m0, n0);
    bool chained = false;
    for (int j = local; j < mtx * ntn; j += nl) {
        f32x16 acc[MI][2];
        zero_acc<MI>(acc);
        const int cm0 = m0, cn0 = n0;
        const bool has_next = (EPI != E_PE) && (j + nl < mtx * ntn);
        if (j + nl < mtx * ntn) TILE_MN(j + nl, m0, n0);
        gemm_mainloop<MI>(acc, A + (size_t)cm0 * K, K, Bt + (size_t)cn0 * K, K, K, lds, ra, rb, chained, A + (size_t)m0 * K, Bt + (size_t)n0 * K, has_next);
        chained = has_next;
        if constexpr (EPI == E_INPROJ0) {
            const int tt = cn0 / 512;
            bf16_t* Q = (bf16_t*)(ws + WS_Q);
#pragma unroll
            for (int mi = 0; mi < MI; ++mi) {
                const int row = cm0 + WR * wm + 32 * mi + l32;
                const float rs = rstd_of(ssq, row);
                const bool pr = row < MP;
                const int sb_ = (row - MP) >> 6, st_ = (row - MP) & 63;
                float kss = 0.f;
#pragma unroll
                for (int ni = 0; ni < 2; ++ni)
#pragma unroll
                    for (int g4 = 0; g4 < 4; ++g4) {
                        const int col = cn0 + 64 * wn + 32 * ni + 8 * g4 + 4 * hi, cseg = col - tt * 512;
                        f32x4 v = {acc[mi][ni][4 * g4], acc[mi][ni][4 * g4 + 1], acc[mi][ni][4 * g4 + 2], acc[mi][ni][4 * g4 + 3]};
                        v = v * rs;
                        if (tt == 0 || tt == 3) {
                            v = v * QS;
                            *(u32x2*)(Q + (size_t)row * 1024 + (tt == 3 ? 512 : 0) + cseg) = (u32x2){cvtpk(v[0], v[1]), cvtpk(v[2], v[3])};
                        } else {
                            const int type = tt >= 3;
                            const bool isk = (tt == 1 || tt == 4);
                            size_t oo;
                            if (isk) oo = pr ? (type ? O_PS_K : O_PF_K) : (type ? O_SS_K : O_SF_K); else oo = pr ? (type ? O_PS_V : O_PF_V) : (type ? O_SS_V : O_SF_V);
                            *(f32x4*)(p.out + oo + (size_t)(pr ? row : row - MP) * 512 + cseg) = v;
                            if (isk) {
                                kss += (v[0] * v[0] + v[1] * v[1]) + (v[2] * v[2] + v[3] * v[3]);
                                bf16_t* kd = pr ? (bf16_t*)(ws + WS_KP) + (size_t)row * 1024 : (bf16_t*)(ws + WS_KS) + (size_t)(sb_ * TS + PAST + st_) * 1024;
                                *(u32x2*)(kd + type * 512 + cseg) = (u32x2){cvtpk(v[0], v[1]), cvtpk(v[2], v[3])};
                            } else {
                                const int head = cseg >> 6, d = cseg & 63;
                                bf16_t* vd; size_t ldv; int t;
                                if (pr) { const int b = row >> 14; t = row & (S - 1); ldv = S; vd = (bf16_t*)(ws + WS_VTP) + ((size_t)((type * 2 + b) * 8 + head) * 64 + d) * S; }
                                else { t = PAST + st_; ldv = TS; vd = (bf16_t*)(ws + WS_VTS) + ((size_t)((type * 16 + sb_) * 8 + head) * 64 + d) * TS; }
                                const int pos = (t & ~63) | permkv(t & 63);
                                const unsigned w01 = cvtpk(v[0], v[1]), w23 = cvtpk(v[2], v[3]);
                                vd[pos] = (bf16_t)(w01 & 0xffff); vd[ldv + pos] = (bf16_t)(w01 >> 16); vd[2 * ldv + pos] = (bf16_t)(w23 & 0xffff); vd[3 * ldv + pos] = (bf16_t)(w23 >> 16);
                            }
                        }
                    }
                if (tt == 1) {
                    kss += __shfl_xor(kss, 32);
#pragma unroll
                    for (int o = 1; o < 32; o <<= 1) kss = fmaxf(kss, __shfl_xor(kss, o));
                    const int head = (cn0 + 64 * wn - 512) >> 6;
                    if (lane == 0) atomicMax((unsigned*)(ws + WS_KMAX) + (pr ? (row >> 14) * 8 + head : 16 + sb_ * 8 + head), __float_as_uint(kss));
                }
            }
        }
        if constexpr (EPI == E_INPROJ1) {
            bf16_t* Q = (bf16_t*)(ws + WS_Q);
            const float* rope = (const float*)(ws + WS_ROPE);
            const int tt = cn0 < 1024 ? 0 : (cn0 < 1280 ? 1 : 2);
#pragma unroll
            for (int mi = 0; mi < MI; ++mi) {
                const int row = cm0 + WR * wm + 32 * mi + l32;
                const float rs = rstd_of(ssq + 3 * M, row);
                const bool pr = row < MP;
                const int sb_ = (row - MP) >> 6, st_ = (row - MP) & 63;
                const int pos = pr ? (row & (S - 1)) : PAST + st_;
                if (tt < 2) {
                    const f32x4 cs0 = *(const f32x4*)(rope + (size_t)pos * 16 + 8 * hi), cs1 = *(const f32x4*)(rope + (size_t)pos * 16 + 8 * hi + 4);
                    const float cc[4] = {cs0[0], cs0[2], cs1[0], cs1[2]}, sn[4] = {cs0[1], cs0[3], cs1[1], cs1[3]};
#pragma unroll
                    for (int e = 0; e < 4; ++e) { const float x1 = acc[mi][0][e], x2 = acc[mi][0][4 + e]; acc[mi][0][e] = x1 * cc[e] - x2 * sn[e]; acc[mi][0][4 + e] = x2 * cc[e] + x1 * sn[e]; }
                }
#pragma unroll
                for (int ni = 0; ni < 2; ++ni)
#pragma unroll
                    for (int g4 = 0; g4 < 4; ++g4) {
                        const int col = cn0 + 64 * wn + 32 * ni + 8 * g4 + 4 * hi;
                        f32x4 v = {acc[mi][ni][4 * g4], acc[mi][ni][4 * g4 + 1], acc[mi][ni][4 * g4 + 2], acc[mi][ni][4 * g4 + 3]};
                        v = v * rs;
                        if (tt == 0) { v = v * QS; *(u32x2*)(Q + (size_t)row * 1024 + col) = (u32x2){cvtpk(v[0], v[1]), cvtpk(v[2], v[3])}; }
                        else {
                            const int cseg = col - (tt == 1 ? 1024 : 1280);
                            if (pr) { const int t = row & (S - 1), b = row >> 14; if (t >= S - 128) *(f32x4*)(p.out + (tt == 1 ? O_PW_K : O_PW_V) + (size_t)(b * 128 + t - (S - 128)) * 256 + cseg) = v; }
                            else *(f32x4*)(p.out + (tt == 1 ? O_SW_K : O_SW_V) + (size_t)(sb_ * 128 + 64 + st_) * 256 + cseg) = v;
                            if (tt == 1) {
                                bf16_t* kd = pr ? (bf16_t*)(ws + WS_K1P) + (size_t)row * 256 : (bf16_t*)(ws + WS_K1S) + (size_t)(sb_ * 192 + 128 + st_) * 256;
                                *(u32x2*)(kd + cseg) = (u32x2){cvtpk(v[0], v[1]), cvtpk(v[2], v[3])};
                            } else {
                                const int head = cseg >> 6, d = cseg & 63;
                                bf16_t* vd; size_t ldv; int t;
                                if (pr) { const int b = row >> 14; t = row & (S - 1); ldv = S; vd = (bf16_t*)(ws + WS_VT1P) + ((size_t)(b * 4 + head) * 64 + d) * S; }
                                else { t = 128 + st_; ldv = 192; vd = (bf16_t*)(ws + WS_VT1S) + ((size_t)(sb_ * 4 + head) * 64 + d) * 192; }
                                const int ps = (t & ~63) | permkv(t & 63);
                                const unsigned w01 = cvtpk(v[0], v[1]), w23 = cvtpk(v[2], v[3]);
                                vd[ps] = (bf16_t)(w01 & 0xffff); vd[ldv + ps] = (bf16_t)(w01 >> 16); vd[2 * ldv + ps] = (bf16_t)(w23 & 0xffff); vd[3 * ldv + ps] = (bf16_t)(w23 >> 16);
                            }
                        }
                    }
            }
        }
        if constexpr (EPI == E_OUT) {
#pragma unroll
            for (int mi = 0; mi < MI; ++mi) {
                const int row = cm0 + WR * wm + 32 * mi + l32;
                const float* res = layer ? H + (size_t)row * D : (row < MP ? p.in[0] + (size_t)row * D : p.in[1] + (size_t)(row - MP) * D);
#pragma unroll
                for (int ni = 0; ni < 2; ++ni)
#pragma unroll
                    for (int g4 = 0; g4 < 4; ++g4) {
                        const int col = cn0 + 64 * wn + 32 * ni + 8 * g4 + 4 * hi;
                        const f32x4 r = *(const f32x4*)(res + col);
#pragma unroll
                        for (int e = 0; e < 4; ++e) acc[mi][ni][4 * g4 + e] += r[e];
                    }
            }
            store_resid<MI>(acc, cm0, cn0, H, layer ? hb1 : hb0, ssq + (size_t)(layer ? 4 : 1) * M);
        }
        if constexpr (EPI == E_GU) {
            bf16_t* act = (bf16_t*)(ws + WS_ACT);
            const float* sq = ssq + (size_t)(layer ? 4 : 1) * M;
#pragma unroll
            for (int mi = 0; mi < MI; ++mi) {
                const int row = cm0 + WR * wm + 32 * mi + l32;
                const float rs = rstd_of(sq, row);
#pragma unroll
                for (int g4 = 0; g4 < 4; ++g4) {
                    const int col = (cn0 >> 1) + 32 * wn + 8 * g4 + 4 * hi;
                    float o[4];
#pragma unroll
                    for (int e = 0; e < 4; ++e) { const float g = acc[mi][0][4 * g4 + e] * rs, u = acc[mi][1][4 * g4 + e] * rs; o[e] = g * fast_rcp(1.f + fast_exp2(-g * LOG2E)) * u; }
                    *(u32x2*)(act + (size_t)row * DFF + col) = (u32x2){cvtpk(o[0], o[1]), cvtpk(o[2], o[3])};
                }
            }
        }
        if constexpr (EPI == E_DOWN) {
#pragma unroll
            for (int mi = 0; mi < MI; ++mi) {
                const int row = cm0 + WR * wm + 32 * mi + l32;
#pragma unroll
                for (int ni = 0; ni < 2; ++ni)
#pragma unroll
                    for (int g4 = 0; g4 < 4; ++g4) {
                        const int col = cn0 + 64 * wn + 32 * ni + 8 * g4 + 4 * hi;
                        const f32x4 r = *(const f32x4*)(H + (size_t)row * D + col);
#pragma unroll
                        for (int e = 0; e < 4; ++e) acc[mi][ni][4 * g4 + e] += r[e];
                    }
            }
            store_resid<MI>(acc, cm0, cn0, H, layer ? hb0 : hb1, ssq + (size_t)(layer ? 5 : 2) * M);
        }
        if constexpr (EPI == E_PE) {
            f32x16 acp[MI][2];
            zero_acc<MI>(acp);
            gemm_mainloop<MI>(acp, (const bf16_t*)(ws + WS_PB) + ((size_t)layer * M + cm0) * PE, PE, (const bf16_t*)(ws + W_PP) + (size_t)layer * 1024 * 256 + (size_t)cn0 * 256, 256, 256, lds, ra, rb, false, nullptr, nullptr, false);
            const float* sq = ssq + (size_t)(layer ? 5 : 2) * M;
#pragma unroll
            for (int mi = 0; mi < MI; ++mi) {
                const int row = cm0 + WR * wm + 32 * mi + l32;
                const float rs = rstd_of(sq, row);
#pragma unroll
                for (int ni = 0; ni < 2; ++ni)
#pragma unroll
                    for (int g4 = 0; g4 < 4; ++g4) {
                        const int col = cn0 + 64 * wn + 32 * ni + 8 * g4 + 4 * hi;
                        const f32x4 r = *(const f32x4*)(H + (size_t)row * D + col);
#pragma unroll
                        for (int e = 0; e < 4; ++e) { const float gl = acc[mi][ni][4 * g4 + e] * rs; acc[mi][ni][4 * g4 + e] = r[e] + acp[mi][ni][4 * g4 + e] * fast_rcp(1.f + fast_exp2(-gl * LOG2E)); }
                    }
            }
            store_resid<MI>(acc, cm0, cn0, H, layer ? nullptr : hb0, ssq + (size_t)(layer ? 6 : 3) * M);
        }
    }
}

template <int MODE, bool CF = false>
DI void attn_item(const bf16_t* Qw, bf16_t* Ow, int qpos0, bool active, const bf16_t* Kb, int ldk, const bf16_t* Vb, int ldv, const float* cb,
                  int kt_hi, int kt_lo, float sink2, float kmax, char* lds, const float* Kc = nullptr, const float* Vc = nullptr, int ktc = 0) {
    const int tid = threadIdx.x, lane = tid & 63, wave = tid >> 6, l32 = lane & 31, hi = lane >> 5;
    const int r0 = tid >> 3, c8 = tid & 7;
    bf16x8 qf[4];
#pragma unroll
    for (int ks = 0; ks < 4; ++ks) qf[ks] = active ? *(const bf16x8*)(Qw + (size_t)l32 * 1024 + ks * 16 + hi * 8) : (bf16x8){0, 0, 0, 0, 0, 0, 0, 0};
    float m = (MODE == 2) ? sink2 : NEGBIG;
    float l = (MODE == 2 && hi == 0) ? 1.f : 0.f;
    float R = 1.f;
    float bq = 0.f;
    if (MODE == 0) {
        float qq = 0.f;
#pragma unroll
        for (int ks = 0; ks < 4; ++ks)
#pragma unroll
            for (int j = 0; j < 8; ++j) { const float f = __uint_as_float(((unsigned)(unsigned short)qf[ks][j]) << 16); qq += f * f; }
        qq += __shfl_xor(qq, 32);
        bq = sqrtf(qq) * kmax;
    }
    f32x16 o0, o1;
#pragma unroll
    for (int r = 0; r < 16; ++r) { o0[r] = 0.f; o1[r] = 0.f; }
    volatile int* flags = (volatile int*)(lds + 2 * ASTG);
    u32x4 rk, rv; f32x4 rc = {0.f, 0.f, 0.f, 0.f};
    f32x4 fk0, fk1, fv0, fv1; bool stf = false;
#define A_LOAD(kt) do { \
        if (CF && (kt) < ktc) { const float* kp_ = Kc + (size_t)((kt) * 64 + lane) * 512 + wave * 8; const float* vp_ = Vc + (size_t)((kt) * 64 + lane) * 512 + wave * 8; \
            fk0 = *(const f32x4*)kp_; fk1 = *(const f32x4*)(kp_ + 4); fv0 = *(const f32x4*)vp_; fv1 = *(const f32x4*)(vp_ + 4); stf = true; } \
        else { rk = *(const u32x4*)(Kb + (size_t)((kt) * 64 + r0) * ldk + c8 * 8); \
            rv = *(const u32x4*)(Vb + (size_t)r0 * ldv + (kt) * 64 + c8 * 8); stf = false; } \
        if (MODE == 0 && tid < 16) rc = *(const f32x4*)(cb + (kt) * 64 + tid * 4); } while (0)
#define A_STORE(st) do { \
        if (CF && stf) { \
            *(u32x4*)(lds + (st) * ASTG + lane * PITCH + wave * 16) = (u32x4){cvtpk(fk0[0], fk0[1]), cvtpk(fk0[2], fk0[3]), cvtpk(fk1[0], fk1[1]), cvtpk(fk1[2], fk1[3])}; \
            bf16_t* vt_ = (bf16_t*)(lds + (st) * ASTG + 64 * PITCH) + (wave * 8) * (PITCH / 2) + permkv(lane); \
            const unsigned w0_ = cvtpk(fv0[0], fv0[1]), w1_ = cvtpk(fv0[2], fv0[3]), w2_ = cvtpk(fv1[0], fv1[1]), w3_ = cvtpk(fv1[2], fv1[3]); \
            vt_[0] = (bf16_t)(w0_ & 0xffff); vt_[PITCH / 2] = (bf16_t)(w0_ >> 16); vt_[2 * (PITCH / 2)] = (bf16_t)(w1_ & 0xffff); vt_[3 * (PITCH / 2)] = (bf16_t)(w1_ >> 16); \
            vt_[4 * (PITCH / 2)] = (bf16_t)(w2_ & 0xffff); vt_[5 * (PITCH / 2)] = (bf16_t)(w2_ >> 16); vt_[6 * (PITCH / 2)] = (bf16_t)(w3_ & 0xffff); vt_[7 * (PITCH / 2)] = (bf16_t)(w3_ >> 16); } \
        else { *(u32x4*)(lds + (st) * ASTG + r0 * PITCH + c8 * 16) = rk; \
            *(u32x4*)(lds + (st) * ASTG + 64 * PITCH + r0 * PITCH + c8 * 16) = rv; } \
        if (MODE == 0 && tid < 16) *(f32x4*)(lds + (st) * ASTG + 128 * PITCH + tid * 16) = rc; } while (0)
    A_LOAD(kt_hi); A_STORE(0);
    if (kt_hi > kt_lo) A_LOAD(kt_hi - 1);
    __syncthreads();
    const int qp = qpos0 + l32;
    int it = 0;
    for (int kt = kt_hi; kt >= kt_lo; --kt, ++it) {
        const int st = it & 1;
        if (kt > kt_lo) A_STORE(st ^ 1);
        if (kt > kt_lo + 1) A_LOAD(kt - 2);
        __builtin_amdgcn_sched_barrier(0);
        const int ts = kt * 64;
        bool skip = !active;
        bool lane_alive = true;
        if (MODE == 0) skip = skip || (ts > qpos0 + 31);
        if (MODE == 1) skip = skip || (ts >= qpos0 + 31);
        if (!skip) {
            const char* Ks = lds + st * ASTG + l32 * PITCH + hi * 16;
            const char* Vs = lds + st * ASTG + 64 * PITCH + l32 * PITCH + hi * 16;
            f32x16 s0, s1;
#pragma unroll
            for (int r = 0; r < 16; ++r) { s0[r] = 0.f; s1[r] = 0.f; }
#pragma unroll
            for (int ks = 0; ks < 4; ++ks) {
                const bf16x8 k0 = *(const bf16x8*)(Ks + ks * 32), k1 = *(const bf16x8*)(Ks + 32 * PITCH + ks * 32);
                s0 = mfma32(k0, qf[ks], s0); s1 = mfma32(k1, qf[ks], s1);
            }
            if (MODE == 0) {
                const float* cbs = (const float*)(lds + st * ASTG + 128 * PITCH);
#pragma unroll
                for (int g4 = 0; g4 < 4; ++g4) {
                    const f32x4 c0 = *(const f32x4*)(cbs + 8 * g4 + 4 * hi), c1 = *(const f32x4*)(cbs + 32 + 8 * g4 + 4 * hi);
#pragma unroll
                    for (int e = 0; e < 4; ++e) { s0[4 * g4 + e] -= c0[e]; s1[4 * g4 + e] -= c1[e]; }
                }
            }
            if (MODE != 1) {
                if (MODE == 0 && ts + 63 > qpos0) {
#pragma unroll
                    for (int r = 0; r < 16; ++r) { const int kv = ts + crow(r, hi); if (kv > qp) s0[r] = NEGBIG; if (kv + 32 > qp) s1[r] = NEGBIG; }
                }
                float mx;
                if (MODE == 0) {
                    mx = max3f(s0[0], s1[0], s0[1]);
                    mx = max3f(mx, s1[1], s0[2]);
#pragma unroll
                    for (int r = 2; r < 15; ++r) mx = max3f(mx, s1[r], s0[r + 1]);
                    mx = fmaxf(mx, s1[15]);
                } else {
                    mx = fmaxf(s0[0], s1[0]);
#pragma unroll
                    for (int r = 1; r < 16; ++r) mx = fmaxf(mx, fmaxf(s0[r], s1[r]));
                }
                mx = fmaxf(mx, __shfl_xor(mx, 32));
                const float mn = fmaxf(m, mx);
                if (__any(mn > m)) {
                    const float al = fast_exp2(m - mn);
                    l *= al;
#pragma unroll
                    for (int r = 0; r < 16; ++r) { o0[r] *= al; o1[r] *= al; }
                    m = mn;
                }
                float ls = 0.f;
#pragma unroll
                for (int r = 0; r < 16; ++r) { s0[r] = fast_exp2(s0[r] - m); s1[r] = fast_exp2(s1[r] - m); ls += s0[r] + s1[r]; }
                l += ls;
                if (MODE == 0) {
                    const float cb0 = *(const float*)(lds + st * ASTG + 128 * PITCH);
                    lane_alive = !((bq - cb0) - m < -170.f);
                }
            } else {
                const bool diag = (ts + 63 >= qpos0);
                f32x16 m0_, m1_;
#pragma unroll
                for (int r = 0; r < 16; ++r) {
                    {
                        const float z = s0[r], e = fast_exp2(-fabsf(z)), rr = fast_rcp(1.f + e), er = e * rr;
                        float sg = z > 0.f ? rr : er, om = z > 0.f ? er : rr;
                        if (diag && !(ts + crow(r, hi) < qp)) { sg = 0.f; om = 1.f; }
                        s0[r] = sg; m0_[r] = om;
                    }
                    {
                        const float z = s1[r], e = fast_exp2(-fabsf(z)), rr = fast_rcp(1.f + e), er = e * rr;
                        float sg = z > 0.f ? rr : er, om = z > 0.f ? er : rr;
                        if (diag && !(ts + 32 + crow(r, hi) < qp)) { sg = 0.f; om = 1.f; }
                        s1[r] = sg; m1_[r] = om;
                    }
                }
                float run = R;
#pragma unroll
                for (int a = 1; a >= 0; --a)
#pragma unroll
                    for (int g4 = 3; g4 >= 0; --g4) {
                        const float om0 = a ? m1_[4 * g4] : m0_[4 * g4], om1 = a ? m1_[4 * g4 + 1] : m0_[4 * g4 + 1], om2 = a ? m1_[4 * g4 + 2] : m0_[4 * g4 + 2], om3 = a ? m1_[4 * g4 + 3] : m0_[4 * g4 + 3];
                        const float G = (om0 * om1) * (om2 * om3);
                        const float PG = __shfl_xor(G, 32);
                        const float b3 = hi ? run : run * PG;
                        const float b2 = b3 * om3, b1 = b2 * om2, b0 = b1 * om1;
                        if (a) { s1[4 * g4] *= b0; s1[4 * g4 + 1] *= b1; s1[4 * g4 + 2] *= b2; s1[4 * g4 + 3] *= b3; }
                        else { s0[4 * g4] *= b0; s0[4 * g4 + 1] *= b1; s0[4 * g4 + 2] *= b2; s0[4 * g4 + 3] *= b3; }
                        run = run * (G * PG);
                    }
                R = run;
            }
            bf16x8 pf[2][2];
#pragma unroll
            for (int sp = 0; sp < 2; ++sp) {
                pf[0][sp] = __builtin_bit_cast(bf16x8, (u32x4){cvtpk(s0[8 * sp], s0[8 * sp + 1]), cvtpk(s0[8 * sp + 2], s0[8 * sp + 3]), cvtpk(s0[8 * sp + 4], s0[8 * sp + 5]), cvtpk(s0[8 * sp + 6], s0[8 * sp + 7])});
                pf[1][sp] = __builtin_bit_cast(bf16x8, (u32x4){cvtpk(s1[8 * sp], s1[8 * sp + 1]), cvtpk(s1[8 * sp + 2], s1[8 * sp + 3]), cvtpk(s1[8 * sp + 4], s1[8 * sp + 5]), cvtpk(s1[8 * sp + 6], s1[8 * sp + 7])});
            }
#pragma unroll
            for (int a = 0; a < 2; ++a)
#pragma unroll
                for (int sp = 0; sp < 2; ++sp) {
                    const bf16x8 v0 = *(const bf16x8*)(Vs + (a * 32 + sp * 16) * 2), v1 = *(const bf16x8*)(Vs + 32 * PITCH + (a * 32 + sp * 16) * 2);
                    o0 = mfma32(v0, pf[a][sp], o0); o1 = mfma32(v1, pf[a][sp], o1);
                }
        }
        __builtin_amdgcn_sched_barrier(0);
        if (MODE <= 1) { const int alive = (active && (MODE == 1 ? __any(R > 0.f) : (skip || __any(lane_alive)))) ? 1 : 0; if (lane == 0) flags[st * 8 + wave] = alive; }
        __syncthreads();
        if (MODE <= 1) { int any = 0;
#pragma unroll
            for (int w = 0; w < 8; ++w) any |= flags[st * 8 + w];
            if (any == 0) break; }
    }
#undef A_LOAD
#undef A_STORE
    if (active) {
        float inv = 1.f;
        if (MODE != 1) { const float lt = l + __shfl_xor(l, 32); inv = 1.0f / lt; }
#pragma unroll
        for (int g4 = 0; g4 < 4; ++g4) {
            *(u32x2*)(Ow + (size_t)l32 * 1024 + 8 * g4 + 4 * hi) = (u32x2){cvtpk(o0[4 * g4] * inv, o0[4 * g4 + 1] * inv), cvtpk(o0[4 * g4 + 2] * inv, o0[4 * g4 + 3] * inv)};
            *(u32x2*)(Ow + (size_t)l32 * 1024 + 32 + 8 * g4 + 4 * hi) = (u32x2){cvtpk(o1[4 * g4] * inv, o1[4 * g4 + 1] * inv), cvtpk(o1[4 * g4 + 2] * inv, o1[4 * g4 + 3] * inv)};
        }
    }
    __syncthreads();
}

template <int MODE>
DI void ab_prompt_item(const Params& p, int bh, int qb, char* lds) {
    const int wave = threadIdx.x >> 6;
    const int b = bh >> 3, h = bh & 7;
    bf16_t* Q = (bf16_t*)(p.ws + WS_Q);
    const size_t row0 = (size_t)b * S + qb * 256 + 32 * wave;
    const int colq = MODE * 512 + h * 64;
    const bf16_t* Kb = (const bf16_t*)(p.ws + WS_KP) + (size_t)b * S * 1024 + colq;
    const bf16_t* Vb = (const bf16_t*)(p.ws + WS_VTP) + (size_t)((MODE * 2 + b) * 8 + h) * 64 * S;
    const float* cb = (const float*)(p.ws + WS_C2P) + (size_t)bh * S;
    attn_item<MODE>(Q + row0 * 1024 + colq, Q + row0 * 1024 + colq, qb * 256 + 32 * wave, true, Kb, 1024, Vb, S, cb, 4 * qb + 3, 0, 0.f, MODE == 0 ? sqrtf(__uint_as_float(((const unsigned*)(p.ws + WS_KMAX))[bh])) * 1.004f : 0.f, lds);
}
template <int MODE>
DI void ab_sample_item(const Params& p, int bh, char* lds) {
    const int wave = threadIdx.x >> 6;
    const int b = bh >> 3, h = bh & 7;
    bf16_t* Q = (bf16_t*)(p.ws + WS_Q);
    const int wv = wave & 1;
    const size_t row0 = (size_t)MP + b * 64 + 32 * wv;
    const int colq = MODE * 512 + h * 64;
    const bf16_t* Kb = (const bf16_t*)(p.ws + WS_KS) + (size_t)b * TS * 1024 + colq;
    const bf16_t* Vb = (const bf16_t*)(p.ws + WS_VTS) + (size_t)((MODE * 16 + b) * 8 + h) * 64 * TS;
    const float* cb = (const float*)(p.ws + WS_C2S) + (size_t)bh * TS;
    attn_item<MODE, true>(Q + row0 * 1024 + colq, Q + row0 * 1024 + colq, PAST + 32 * wv, wave < 2, Kb, 1024, Vb, TS, cb, 32, 0, 0.f, MODE == 0 ? sqrtf(__uint_as_float(((const unsigned*)(p.ws + WS_KMAX))[16 + bh])) * 1.004f : 0.f, lds,
                          p.in[MODE ? 5 : 2] + (size_t)b * PAST * 512 + h * 64, p.in[MODE ? 6 : 3] + (size_t)b * PAST * 512 + h * 64, 32);
}

DI void phase_attn0(const Params& p, char* lds) {
    const int G = gridDim.x, j = blockIdx.x;
    for (int k = 0; k * G < 1024; ++k) {
        const int rank = k * G + ((k & 1) ? G - 1 - j : j);
        if (rank >= 1024) continue;
        ab_prompt_item<0>(p, rank & 15, 63 - (rank >> 4), lds);
    }
    for (int i = G - 1 - j; i < 128 + 128 + 1024; i += G) {
        if (i < 128) ab_sample_item<0>(p, i, lds);
        else if (i < 256) ab_sample_item<1>(p, i - 128, lds);
        else { const int r = i - 256; ab_prompt_item<1>(p, r & 15, r >> 4, lds); }
    }
}

DI void phase_attn1(const Params& p, char* lds) {
    const int wave = threadIdx.x >> 6;
    bf16_t* Q = (bf16_t*)(p.ws + WS_Q);
    const float* sinks = p.in[16];
    const int nitems = (M / 64) * 4;
    for (int i = blockIdx.x; i < nitems; i += gridDim.x) {
        const int kvh = i & 3, ch = i >> 2;
        const int rowc = ch * 64, row0 = rowc + 32 * (wave >> 2);
        const int head = kvh * 4 + (wave & 3);
        const float sink2 = sinks[head] * LOG2E;
        const bf16_t* Kb; const bf16_t* Vb; int ldv, kt_hi, kt_lo;
        if (rowc < MP) {
            const int b = rowc >> 14, t = rowc & (S - 1), c = t >> 6;
            Kb = (const bf16_t*)(p.ws + WS_K1P) + (size_t)b * S * 256 + kvh * 64;
            Vb = (const bf16_t*)(p.ws + WS_VT1P) + (size_t)(b * 4 + kvh) * 64 * S; ldv = S;
            kt_hi = c; kt_lo = c >= 2 ? c - 2 : 0;
        } else {
            const int b = (rowc - MP) >> 6;
            Kb = (const bf16_t*)(p.ws + WS_K1S) + (size_t)b * 192 * 256 + kvh * 64;
            Vb = (const bf16_t*)(p.ws + WS_VT1S) + (size_t)(b * 4 + kvh) * 64 * 192; ldv = 192;
            kt_hi = 2; kt_lo = 0;
        }
        attn_item<2>(Q + (size_t)row0 * 1024 + head * 64, Q + (size_t)row0 * 1024 + head * 64, 0, true, Kb, 256, Vb, ldv, nullptr, kt_hi, kt_lo, sink2, 0.f, lds);
    }
}

DI void phase_final(const Params& p) {
    const int lane = threadIdx.x & 63, wave = threadIdx.x >> 6;
    const float* ssq = (const float*)(p.ws + WS_SSQ) + (size_t)6 * M;
    const float* g = p.in[25];
    f32x4 gv[4];
#pragma unroll
    for (int j = 0; j < 4; ++j) gv[j] = *(const f32x4*)(g + 256 * j + 4 * lane);
    for (int row = blockIdx.x * NW + wave; row < M; row += gridDim.x * NW) {
        const float rs = rstd_of(ssq, row);
        float* y = p.out + (size_t)row * D;
#pragma unroll
        for (int j = 0; j < 4; ++j) { f32x4 v = *(f32x4*)(y + 256 * j + 4 * lane); v = v * rs * gv[j]; *(f32x4*)(y + 256 * j + 4 * lane) = v; }
    }
}

#define LAS __attribute__((address_space(3)))
#define XB_TMO      128
#define XB_XCNT(j)  (256  + 64 * (j))
#define XB_XSUB(j)  (1280 + 64 * (j))
#define XB_XGEN(j)  (2304 + 64 * (j))
#define XB_TOP      3328
#define XB_TOPGEN   3392
#define XCD_BAR_WORDS 3456
#define XB_SPIN_CAP (1u << 18)

__device__ __forceinline__ unsigned xb_ld(unsigned* p)              { return __hip_atomic_load(p, __ATOMIC_RELAXED, __HIP_MEMORY_SCOPE_AGENT); }
__device__ __forceinline__ unsigned xb_add(unsigned* p, unsigned v) { return __hip_atomic_fetch_add(p, v, __ATOMIC_RELAXED, __HIP_MEMORY_SCOPE_AGENT); }
__device__ __forceinline__ unsigned xb_xcc_id() { return (unsigned)__builtin_amdgcn_s_getreg((3 << 11) | 20) & 0xFu; }
#define XB_SPIN(cond, bar) do { unsigned _sp = 0; while (cond) { __builtin_amdgcn_s_sleep(1); \
    if ((++_sp & 255u) == 0u) { if (xb_ld(&(bar)[XB_TMO])) break; if (_sp > XB_SPIN_CAP) { atomicAdd(&(bar)[XB_TMO], 1u); break; } } } } while (0)

struct XcdBarrier {
    unsigned* bar; unsigned x;
    volatile LAS unsigned* st;
};

__device__ __forceinline__ XcdBarrier xcd_barrier_post(unsigned* bar, volatile LAS unsigned* st) {
    XcdBarrier b; b.bar = bar; b.x = xb_xcc_id(); b.st = st;
    if (threadIdx.x == 0) (void)xb_add(&bar[XB_XCNT(b.x)], 1u);
    return b;
}
__device__ __forceinline__ void xcd_barrier_complete(unsigned* bar, unsigned x, unsigned& nloc, unsigned& nx) {
    const unsigned G = gridDim.x * gridDim.y * gridDim.z;
    unsigned sum, cnt, mine, sp = 0u;
    for (;;) {
        sum = 0u; cnt = 0u; mine = 0u;
#pragma unroll
        for (unsigned j = 0; j < 16; ++j) { const unsigned c = xb_ld(&bar[XB_XCNT(j)]); sum += c; cnt += (c > 0u) ? 1u : 0u; mine = (j == x) ? c : mine; }
        if (sum == G) break;
        __builtin_amdgcn_s_sleep(1);
        if ((++sp & 255u) == 0u) { if (xb_ld(&bar[XB_TMO])) break; if (sp > XB_SPIN_CAP) { atomicAdd(&bar[XB_TMO], 1u); break; } }
    }
    nloc = mine > 0u ? mine : 1u; nx = cnt > 0u ? cnt : 1u;
}

__device__ __forceinline__ void xcd_barrier(const XcdBarrier& b) {
    asm volatile("s_waitcnt vmcnt(0)" ::: "memory");
    __syncthreads();
    if (threadIdx.x == 0) {
        unsigned* bar = b.bar;
        __builtin_amdgcn_s_waitcnt(0);
        unsigned nloc = b.st[0], nx = b.st[1];
        if (nloc == 0u) { xcd_barrier_complete(bar, b.x, nloc, nx); b.st[0] = nloc; b.st[1] = nx; }
        const unsigned old = xb_add(&bar[XB_XSUB(b.x)], 1u);
        const unsigned gen = old / nloc;
        if (old + 1u == (gen + 1u) * nloc) {
            __builtin_amdgcn_fence(__ATOMIC_RELEASE, "agent");
            asm volatile("s_waitcnt vmcnt(0)" ::: "memory");
            const unsigned og = xb_add(&bar[XB_TOP], 1u);
            const unsigned tg = og / nx;
            if (og + 1u == (tg + 1u) * nx) xb_add(&bar[XB_TOPGEN], 1u);
            else XB_SPIN(xb_ld(&bar[XB_TOPGEN]) == tg, bar);
            __builtin_amdgcn_fence(__ATOMIC_ACQUIRE, "agent");
            xb_add(&bar[XB_XGEN(b.x)], 1u);
            asm volatile("s_waitcnt vmcnt(0)" ::: "memory");
        } else {
            XB_SPIN(xb_ld(&bar[XB_XGEN(b.x)]) == gen, bar);
            __builtin_amdgcn_fence(__ATOMIC_ACQUIRE, "agent");
            asm volatile("s_waitcnt vmcnt(0)" ::: "memory");
        }
    }
    __syncthreads();
}


__global__ void __launch_bounds__(NTHR, 2) trunk_fwd(Params p) {
    __shared__ __attribute__((aligned(16))) char lds[LDS_BYTES];
    __shared__ __attribute__((aligned(16))) unsigned bar_st[4];
    if (threadIdx.x < 4) bar_st[threadIdx.x] = 0u;
    __syncthreads();
    const XcdBarrier gbar = xcd_barrier_post((unsigned*)(p.ws + WS_BAR), (volatile LAS unsigned*)bar_st);
#define PHASE(k, ...) if (p.ph_lo <= (k) && (k) < p.ph_hi) { __VA_ARGS__; if ((k) + 1 < p.ph_hi) { if ((k) == 0) cg::this_grid().sync(); else xcd_barrier(gbar); } }
    PHASE(0, phase_prep(p, lds))
    int cfirst = blockIdx.x, kfirst = (int)gridDim.x - 1 - (int)blockIdx.x, cstride = gridDim.x;
    if (gridDim.x == 256) { const int local = blockIdx.x >> 3, s = (blockIdx.x & 7) * 24 + (local - 8); cstride = 192; cfirst = local >= 8 ? s : 1 << 20; kfirst = local >= 8 ? 191 - s : 1 << 20; }
    PHASE(1, gemm_phase<E_INPROJ0, 3>(p, 0, lds); cumsum_items(p, lds, cfirst, cstride); kmax_items(p, lds, kfirst, cstride))
    PHASE(2, phase_attn0(p, lds))
    PHASE(3, gemm_phase<E_OUT, 3>(p, 0, lds))
    PHASE(4, gemm_phase<E_GU, 3>(p, 0, lds))
    PHASE(5, gemm_phase<E_DOWN, 3>(p, 0, lds))
    PHASE(6, gemm_phase<E_PE, 2>(p, 0, lds))
    PHASE(7, gemm_phase<E_INPROJ1, 3>(p, 1, lds))
    PHASE(8, phase_attn1(p, lds))
    PHASE(9, gemm_phase<E_OUT, 3>(p, 1, lds))
    PHASE(10, gemm_phase<E_GU, 3>(p, 1, lds))
    PHASE(11, gemm_phase<E_DOWN, 3>(p, 1, lds))
    PHASE(12, gemm_phase<E_PE, 2>(p, 1, lds))
    PHASE(13, phase_final(p))
#undef PHASE
}

extern "C" void kernel_launch(void* const* d_in, const int* in_sizes, int n_in, void* d_out, int out_size, void* d_ws, size_t ws_size, hipStream_t stream) {
    static int grid = 0;
    if (grid == 0) {
        if (n_in != 26 || (size_t)out_size != O_END || ws_size < WS_END) {
            fprintf(stderr, "kernel_launch: unexpected shapes: n_in %d out %d (want %zu) ws %zu (need %zu)\n", n_in, out_size, (size_t)O_END, ws_size, (size_t)WS_END);
            grid = -1; return;
        }
        int dev = 0, cus = 0, per_cu = 0;
        hipGetDevice(&dev);
        hipDeviceGetAttribute(&cus, hipDeviceAttributeMultiprocessorCount, dev);
        hipOccupancyMaxActiveBlocksPerMultiprocessor(&per_cu, (const void*)trunk_fwd, NTHR, 0);
        if (per_cu < 1) per_cu = 1;
        if (per_cu > 1) per_cu = 1;
        grid = cus * per_cu;
    }
    if (grid < 0) return;
    Params p{};
    for (int i = 0; i < 26; ++i) p.in[i] = (const float*)d_in[i];
    p.out = (float*)d_out; p.ws = (unsigned char*)d_ws;
    (void)hipMemsetAsync((unsigned char*)d_ws + WS_KMAX, 0, 1024 + 16384, stream);
#if MULTI_LAUNCH
    for (int ph = 0; ph < 14; ++ph) { p.ph_lo = ph; p.ph_hi = ph + 1; hipLaunchKernelGGL(trunk_fwd, dim3(grid), dim3(NTHR), 0, stream, p); }
#else
    p.ph_lo = 0; p.ph_hi = 14;
    void* args[] = {&p};
    hipError_t e = hipLaunchCooperativeKernel((const void*)trunk_fwd, dim3(grid), dim3(NTHR), args, 0, stream);
    if (e != hipSuccess) fprintf(stderr, "cooperative launch failed: %s (grid %d)\n", hipGetErrorString(e), grid);
#endif
}
```

```cpp
#include <hip/hip_runtime.h>
#include <hip/hip_cooperative_groups.h>
#include <cstdio>
#include <cstdint>
namespace cg = cooperative_groups;

#ifndef MULTI_LAUNCH
#define MULTI_LAUNCH 0
#endif

typedef unsigned short bf16_t;
typedef short bf16x8 __attribute__((ext_vector_type(8)));
typedef float f32x16 __attribute__((ext_vector_type(16)));
typedef float f32x4 __attribute__((ext_vector_type(4)));
typedef float f32x2 __attribute__((ext_vector_type(2)));
typedef unsigned u32x4 __attribute__((ext_vector_type(4)));
typedef unsigned u32x2 __attribute__((ext_vector_type(2)));
typedef __bf16 bf16x2_t __attribute__((ext_vector_type(2)));
#define DI __device__ __forceinline__

constexpr int S = 16384, MP = 32768, MS = 1024, M = MP + MS, D = 1024, DFF = 2816, PAST = 2048, TS = PAST + 64, PE = 256;
constexpr int NTHR = 512, NW = 8;
constexpr float EPS = 1e-6f, LOG2E = 1.4426950408889634f, QS = 0.125f * 1.4426950408889634f, NEGBIG = -1e30f;

constexpr size_t O_Y = 0;
constexpr size_t O_PF_K = (size_t)M * D;
constexpr size_t O_PF_V = O_PF_K + (size_t)MP * 512;
constexpr size_t O_PF_LF = O_PF_V + (size_t)MP * 512;
constexpr size_t O_PS_K = O_PF_LF + (size_t)MP * 8;
constexpr size_t O_PS_V = O_PS_K + (size_t)MP * 512;
constexpr size_t O_PW_K = O_PS_V + (size_t)MP * 512;
constexpr size_t O_PW_V = O_PW_K + 2 * 128 * 256;
constexpr size_t O_SF_K = O_PW_V + 2 * 128 * 256;
constexpr size_t O_SF_V = O_SF_K + (size_t)MS * 512;
constexpr size_t O_SF_LF = O_SF_V + (size_t)MS * 512;
constexpr size_t O_SS_K = O_SF_LF + (size_t)MS * 8;
constexpr size_t O_SS_V = O_SS_K + (size_t)MS * 512;
constexpr size_t O_SW_K = O_SS_V + (size_t)MS * 512;
constexpr size_t O_SW_V = O_SW_K + 16 * 128 * 256;
constexpr size_t O_END = O_SW_V + 16 * 128 * 256;

constexpr size_t al256(size_t x) { return (x + 255) & ~(size_t)255; }
constexpr size_t W_AB_IN = 0;
constexpr size_t W_AB_OUT = W_AB_IN + (size_t)3072 * 1024 * 2;
constexpr size_t W_C_IN = W_AB_OUT + (size_t)1024 * 1024 * 2;
constexpr size_t W_C_OUT = W_C_IN + (size_t)1536 * 1024 * 2;
constexpr size_t W_GU = W_C_OUT + (size_t)1024 * 1024 * 2;
constexpr size_t W_DN = W_GU + (size_t)2 * 5632 * 1024 * 2;
constexpr size_t W_PG = W_DN + (size_t)2 * 1024 * 2816 * 2;
constexpr size_t W_PP = W_PG + (size_t)2 * 1024 * 1024 * 2;
constexpr size_t WS_SSQ = W_PP + (size_t)2 * 1024 * 256 * 2;
constexpr size_t WS_ROPE = al256(WS_SSQ + (size_t)7 * M * 4);
constexpr size_t WS_C2P = WS_ROPE + (size_t)16384 * 16 * 4;
constexpr size_t WS_C2S = WS_C2P + (size_t)16 * 16384 * 4;
constexpr size_t WS_LOGF = WS_C2S + (size_t)128 * TS * 4;
constexpr size_t WS_KMAX = al256(WS_LOGF + (size_t)M * 8 * 4);
constexpr size_t WS_BAR = WS_KMAX + 1024;
constexpr size_t WS_K1S = WS_BAR + 16384;
constexpr size_t WS_VT1S = WS_K1S + (size_t)16 * 192 * 256 * 2;
constexpr size_t WS_HB0 = al256(WS_VT1S + (size_t)16 * 4 * 64 * 192 * 2);
constexpr size_t WS_HB1 = WS_HB0 + (size_t)M * 1024 * 2;
constexpr size_t WS_R = WS_HB1 + (size_t)M * 1024 * 2;
constexpr size_t WS_Q = WS_R;
constexpr size_t WS_KP = WS_Q + (size_t)M * 1024 * 2;
constexpr size_t WS_KS = WS_KP + (size_t)MP * 1024 * 2;
constexpr size_t WS_VTP = WS_KS + (size_t)16 * TS * 1024 * 2;
constexpr size_t WS_PB = WS_VTP + (size_t)2 * 2 * 8 * 64 * 16384 * 2;
constexpr size_t WS_END = WS_PB + (size_t)2 * M * 256 * 2;
constexpr size_t WS_ACT = WS_R;
constexpr size_t WS_VTS = WS_HB0;
constexpr size_t WS_K1P = WS_VTP;
constexpr size_t WS_VT1P = WS_VTP + (size_t)MP * 256 * 2;
static_assert((size_t)M * DFF * 2 <= WS_VTP - WS_R, "ACT overlay");
static_assert((size_t)2 * 16 * 8 * 64 * TS * 2 <= (size_t)M * 1024 * 2, "VTS overlay");

struct Params {
    const float* in[26];
    float* out;
    unsigned char* ws;
    int ph_lo, ph_hi;
};

DI unsigned cvtpk(float lo, float hi) { f32x2 v = {lo, hi}; bf16x2_t b = __builtin_convertvector(v, bf16x2_t); return __builtin_bit_cast(unsigned, b); }
DI float wave_sum(float v) {
#pragma unroll
    for (int o = 1; o < 64; o <<= 1) v += __shfl_xor(v, o);
    return v;
}
DI int crow(int r, int hi) { return (r & 3) + 8 * (r >> 2) + 4 * hi; }
DI int permkv(int kv) { return (kv & 0x33) | ((kv & 8) >> 1) | ((kv & 4) << 1); }
DI f32x16 mfma32(bf16x8 a, bf16x8 b, f32x16 c) { return __builtin_amdgcn_mfma_f32_32x32x16_bf16(a, b, c, 0, 0, 0); }
DI float max3f(float a, float b, float c) { float r; asm("v_max3_f32 %0, %1, %2, %3" : "=v"(r) : "v"(a), "v"(b), "v"(c)); return r; }
DI float fast_exp2(float x) { return __builtin_amdgcn_exp2f(x); }
DI float fast_rcp(float x) { return __builtin_amdgcn_rcpf(x); }

constexpr int PITCH = 144;
constexpr int GSTG = 512 * 128;
constexpr int LDS_BYTES = 2 * GSTG;
constexpr int ASTG = 2 * 64 * PITCH + 256;

template <int MAP>
DI void wtrans(const float* W, const float* W2, int K, int Nsrc, bf16_t* Wt, int Ndst, const float* g, float* scr) {
    const int tid = threadIdx.x;
    const int ntn = Ndst / 64, ntiles = (K / 64) * ntn;
    for (int t0 = 2 * (int)blockIdx.x; t0 < ntiles; t0 += 2 * (int)gridDim.x) {
        float v[2][8];
#pragma unroll
        for (int q = 0; q < 2; ++q) {
            const int tile = t0 + q;
            if (tile < ntiles) {
                const int n0 = (tile % ntn) * 64, k0 = (tile / ntn) * 64; const int np = n0 + (tid & 63);
                const float* src = W; int col = np;
                if (MAP == 1) { col = np < 1536 ? np : np + 8; }
                if (MAP == 2) { const int blk = np >> 5; col = (blk >> 1) * 32 + (np & 31); src = (blk & 1) ? W2 : W; }
#pragma unroll
                for (int i = 0; i < 8; ++i) { const int k = i * 8 + (tid >> 6); v[q][i] = src[(size_t)(k0 + k) * Nsrc + col]; if (g) v[q][i] *= g[k0 + k]; }
            }
        }
#pragma unroll
        for (int q = 0; q < 2; ++q)
#pragma unroll
            for (int i = 0; i < 8; ++i) scr[q * 4160 + (i * 8 + (tid >> 6)) * 65 + (tid & 63)] = v[q][i];
        __syncthreads();
#pragma unroll
        for (int q = 0; q < 2; ++q) {
            const int tile = t0 + q;
            if (tile < ntiles) {
                const int n0 = (tile % ntn) * 64, k0 = (tile / ntn) * 64;
                const int nn = tid >> 3, kc = (tid & 7) * 8;
                unsigned w[4];
#pragma unroll
                for (int j = 0; j < 4; ++j) w[j] = cvtpk(scr[q * 4160 + (kc + 2 * j) * 65 + nn], scr[q * 4160 + (kc + 2 * j + 1) * 65 + nn]);
                *(u32x4*)(Wt + (size_t)(n0 + nn) * K + k0 + kc) = (u32x4){w[0], w[1], w[2], w[3]};
            }
        }
        __syncthreads();
    }
}

DI void vtrans(const float* src, int nb, int Tc, int H, bf16_t* dst, int ldv, float* scr) {
    const int tid = threadIdx.x;
    const int ntb = Tc / 64, units = nb * H * ntb;
    for (int u0 = 2 * (int)blockIdx.x; u0 < units; u0 += 2 * (int)gridDim.x) {
        float v[2][8];
#pragma unroll
        for (int q = 0; q < 2; ++q) {
            const int u = u0 + q;
            if (u < units) {
                const int tb = u % ntb, bh = u / ntb, h = bh % H, b = bh / H;
#pragma unroll
                for (int i = 0; i < 8; ++i) { const int t = i * 8 + (tid >> 6), d = tid & 63; v[q][i] = src[((size_t)(b * Tc + tb * 64 + t) * H + h) * 64 + d]; }
            }
        }
#pragma unroll
        for (int q = 0; q < 2; ++q)
#pragma unroll
            for (int i = 0; i < 8; ++i) scr[q * 4160 + (i * 8 + (tid >> 6)) * 65 + (tid & 63)] = v[q][i];
        __syncthreads();
#pragma unroll
        for (int q = 0; q < 2; ++q) {
            const int u = u0 + q;
            if (u < units) {
                const int tb = u % ntb, bh = u / ntb, h = bh % H, b = bh / H;
                const int d = tid >> 3, qq = tid & 7;
                unsigned w[4];
#pragma unroll
                for (int j = 0; j < 4; ++j) {
                    const int p0 = 8 * qq + 2 * j, p1 = p0 + 1;
                    w[j] = cvtpk(scr[q * 4160 + permkv(p0) * 65 + d], scr[q * 4160 + permkv(p1) * 65 + d]);
                }
                *(u32x4*)(dst + ((size_t)(b * H + h) * 64 + d) * ldv + tb * 64 + 8 * qq) = (u32x4){w[0], w[1], w[2], w[3]};
            }
        }
        __syncthreads();
    }
}

DI void phase_prep(const Params& p, char* lds) {
    float* scr = (float*)lds;
    unsigned char* ws = p.ws;
    const int tid = threadIdx.x, lane = tid & 63, wave = tid >> 6;
    const size_t gtid = (size_t)blockIdx.x * NTHR + tid, gthreads = (size_t)gridDim.x * NTHR;
    wtrans<1>(p.in[12], nullptr, 1024, 3080, (bf16_t*)(ws + W_AB_IN), 3072, p.in[11], scr);
    wtrans<0>(p.in[14], nullptr, 1024, 1024, (bf16_t*)(ws + W_AB_OUT), 1024, nullptr, scr);
    wtrans<0>(p.in[15], nullptr, 1024, 1536, (bf16_t*)(ws + W_C_IN), 1536, p.in[11] + 1024, scr);
    wtrans<0>(p.in[17], nullptr, 1024, 1024, (bf16_t*)(ws + W_C_OUT), 1024, nullptr, scr);
    for (int l = 0; l < 2; ++l) {
        wtrans<2>(p.in[19] + (size_t)l * 1024 * DFF, p.in[20] + (size_t)l * 1024 * DFF, 1024, DFF, (bf16_t*)(ws + W_GU) + (size_t)l * 5632 * 1024, 5632, p.in[18] + l * 1024, scr);
        wtrans<0>(p.in[21] + (size_t)l * DFF * 1024, nullptr, DFF, 1024, (bf16_t*)(ws + W_DN) + (size_t)l * 1024 * DFF, 1024, nullptr, scr);
        wtrans<0>(p.in[23] + (size_t)l * 1024 * 1024, nullptr, 1024, 1024, (bf16_t*)(ws + W_PG) + (size_t)l * 1024 * 1024, 1024, p.in[22] + l * 1024, scr);
        wtrans<0>(p.in[24] + (size_t)l * 256 * 1024, nullptr, 256, 1024, (bf16_t*)(ws + W_PP) + (size_t)l * 1024 * 256, 1024, nullptr, scr);
    }
    vtrans(p.in[8], 16, 128, 4, (bf16_t*)(ws + WS_VT1S), 192, scr);
    {
        bf16_t* K1s = (bf16_t*)(ws + WS_K1S);
        const size_t n1 = (size_t)16 * 128 * 32;
        for (size_t u = gtid; u < n1; u += gthreads) {
            const int c8 = (int)(u & 31); const int t = (int)((u >> 5) & 127), b = (int)(u >> 12);
            const float* s = p.in[7] + ((size_t)(b * 128 + t) * 256 + c8 * 8);
            const f32x4 x = *(const f32x4*)s, y = *(const f32x4*)(s + 4);
            *(u32x4*)(K1s + ((size_t)(b * 192 + t) * 256 + c8 * 8)) = (u32x4){cvtpk(x[0], x[1]), cvtpk(x[2], x[3]), cvtpk(y[0], y[1]), cvtpk(y[2], y[3])};
        }
        const size_t n2 = (size_t)2 * 16 * 64 * 64;
        for (size_t u = gtid; u < n2; u += gthreads) {
            const int c4 = (int)(u & 63); const int t = (int)((u >> 6) & 63), b = (int)((u >> 12) & 15), kv = (int)(u >> 16);
            const float* s = (kv ? p.in[8] : p.in[7]) + ((size_t)(b * 128 + 64 + t) * 256 + c4 * 4);
            float* o = p.out + (kv ? O_SW_V : O_SW_K) + ((size_t)(b * 128 + t) * 256 + c4 * 4);
            *(f32x4*)o = *(const f32x4*)s;
        }
    }
    {
        bf16_t* pb = (bf16_t*)(ws + WS_PB);
        const size_t n = (size_t)2 * M * 32;
        for (size_t u0 = gtid; u0 < n; u0 += 4 * gthreads) {
            f32x4 x[4], y[4];
#pragma unroll
            for (int k = 0; k < 4; ++k) {
                const size_t u = u0 + k * gthreads;
                if (u < n) {
                    const int c8 = (int)(u & 31); const size_t lr = u >> 5; const int l = (int)(lr / M), r = (int)(lr % M);
                    const float* s = (r < MP ? p.in[9] + ((size_t)l * MP + r) * PE : p.in[10] + ((size_t)l * MS + (r - MP)) * PE) + c8 * 8;
                    x[k] = *(const f32x4*)s; y[k] = *(const f32x4*)(s + 4);
                }
            }
#pragma unroll
            for (int k = 0; k < 4; ++k) {
                const size_t u = u0 + k * gthreads;
                if (u < n) *(u32x4*)(pb + (u >> 5) * PE + (u & 31) * 8) = (u32x4){cvtpk(x[k][0], x[k][1]), cvtpk(x[k][2], x[k][3]), cvtpk(y[k][0], y[k][1]), cvtpk(y[k][2], y[k][3])};
            }
        }
    }
    {
        float* rope = (float*)(ws + WS_ROPE);
        for (size_t u = gtid; u < (size_t)16384 * 8; u += gthreads) {
            const int i = (int)(u & 7); const int pos = (int)(u >> 3);
            const double inv = pow(500000.0, -(double)i / 8.0), ang = (double)pos * inv;
            rope[2 * u] = (float)cos(ang); rope[2 * u + 1] = (float)sin(ang);
        }
        float* ssq = (float*)(ws + WS_SSQ);
        for (size_t u = gtid; u < (size_t)6 * M; u += gthreads) ssq[M + u] = 0.f;
    }
    {
        __syncthreads();
        const float* wab = p.in[12]; const float* g0 = p.in[11];
        for (int u = tid; u < 8 * 1024; u += NTHR) { const int h = u >> 10, k = u & 1023; scr[u] = g0[k] * wab[(size_t)k * 3080 + 1536 + h]; }
        __syncthreads();
        bf16_t* xb = (bf16_t*)(ws + WS_HB1);
        float* ssq0 = (float*)(ws + WS_SSQ);
        float* logf = (float*)(ws + WS_LOGF);
        const float* bf = p.in[13];
        const int rstep = gridDim.x * NW;
        for (int row0 = blockIdx.x * NW + wave; row0 < M; row0 += 2 * rstep) {
            f32x4 vv[2][4];
#pragma unroll
            for (int q = 0; q < 2; ++q) {
                const int row = row0 + q * rstep;
                if (row < M) {
                    const float* xr = row < MP ? p.in[0] + (size_t)row * D : p.in[1] + (size_t)(row - MP) * D;
#pragma unroll
                    for (int j = 0; j < 4; ++j) vv[q][j] = *(const f32x4*)(xr + 256 * j + 4 * lane);
                }
            }
#pragma unroll
            for (int q = 0; q < 2; ++q) {
                const int row = row0 + q * rstep;
                if (row >= M) break;
                f32x4 v[4]; float ss = 0.f;
#pragma unroll
                for (int j = 0; j < 4; ++j) { v[j] = vv[q][j]; ss += (v[j][0] * v[j][0] + v[j][1] * v[j][1]) + (v[j][2] * v[j][2] + v[j][3] * v[j][3]); }
                ss = wave_sum(ss);
#pragma unroll
                for (int j = 0; j < 4; ++j) *(u32x2*)(xb + (size_t)row * D + 256 * j + 4 * lane) = (u32x2){cvtpk(v[j][0], v[j][1]), cvtpk(v[j][2], v[j][3])};
                const float rstd = 1.0f / sqrtf(ss * (1.0f / D) + EPS);
                float mine = 0.f;
#pragma unroll
                for (int h = 0; h < 8; ++h) {
                    float d = 0.f;
#pragma unroll
                    for (int j = 0; j < 4; ++j) { const f32x4 w = *(const f32x4*)(scr + h * 1024 + 256 * j + 4 * lane); d += (v[j][0] * w[0] + v[j][1] * w[1]) + (v[j][2] * w[2] + v[j][3] * w[3]); }
                    d = wave_sum(d);
                    if (lane == h) mine = d;
                }
                if (lane == 0) ssq0[row] = ss;
                if (lane < 8) {
                    const float x = mine * rstd + bf[lane];
                    const float lf = fminf(x, 0.f) - log1pf(expf(-fabsf(x)));
                    logf[(size_t)row * 8 + lane] = lf;
                    if (row < MP) p.out[O_PF_LF + (size_t)row * 8 + lane] = lf; else p.out[O_SF_LF + (size_t)(row - MP) * 8 + lane] = lf;
                }
            }
        }
        __syncthreads();
    }
}

DI void kmax_items(const Params& p, char* lds, int first, int stride) {
    float* sc = (float*)lds;
    const int tid = threadIdx.x, lane = tid & 63, wave = tid >> 6;
    for (int it = first; it < 128; it += stride) {
        const int b = it >> 3, h = it & 7;
        float mx = 0.f;
        for (int t = tid; t < PAST; t += NTHR) {
            const f32x4* r = (const f32x4*)(p.in[2] + ((size_t)(b * PAST + t) * 8 + h) * 64);
            float ss = 0.f;
#pragma unroll
            for (int c = 0; c < 16; ++c) { const f32x4 w = r[c]; ss += (w[0] * w[0] + w[1] * w[1]) + (w[2] * w[2] + w[3] * w[3]); }
            mx = fmaxf(mx, ss);
        }
#pragma unroll
        for (int o = 1; o < 64; o <<= 1) mx = fmaxf(mx, __shfl_xor(mx, o));
        __syncthreads();
        if (lane == 0) sc[wave] = mx;
        __syncthreads();
        if (tid == 0) { float m = sc[0];
#pragma unroll
            for (int w = 1; w < NW; ++w) m = fmaxf(m, sc[w]);
            atomicMax((unsigned*)(p.ws + WS_KMAX) + 16 + it, __float_as_uint(m)); }
    }
    __syncthreads();
}

DI void cumsum_items(const Params& p, char* lds, int first, int stride) {
    float* sc = (float*)lds;
    const int tid = threadIdx.x;
    const float* logf = (const float*)(p.ws + WS_LOGF);
    for (int it = first; it < 16 + 128; it += stride) {
        int T, per; float* dst;
        const bool pr = it < 16;
        int b, h;
        if (pr) { b = it >> 3; h = it & 7; T = S; per = S / NTHR; dst = (float*)(p.ws + WS_C2P) + (size_t)it * S; }
        else { const int j = it - 16; b = j >> 3; h = j & 7; T = TS; per = (TS + NTHR - 1) / NTHR; dst = (float*)(p.ws + WS_C2S) + (size_t)j * TS; }
        const int t0 = tid * per, t1 = min(T, t0 + per);
        auto ld = [&](int t) -> float {
            if (pr) return logf[((size_t)(b * S + t)) * 8 + h];
            if (t < PAST) return p.in[4][((size_t)(b * PAST + t)) * 8 + h];
            return logf[((size_t)(MP + b * 64 + (t - PAST))) * 8 + h];
        };
        float s = 0.f;
        for (int t = t0; t < t1; ++t) s += ld(t);
        __syncthreads();
        sc[tid] = s;
        __syncthreads();
        for (int o = 1; o < NTHR; o <<= 1) {
            const float a = (tid >= o) ? sc[tid - o] : 0.f;
            __syncthreads();
            sc[tid] += a;
            __syncthreads();
        }
        float run = (tid > 0) ? sc[tid - 1] : 0.f;
        for (int t = t0; t < t1; ++t) { run += ld(t); dst[t] = run * LOG2E; }
        __syncthreads();
    }
}

template <int MI>
DI void gemm_mainloop(f32x16 (&acc)[MI][2], const bf16_t* Aptr, int lda, const bf16_t* Bt, int ldb, int K, char* lds, u32x4 (&ra)[MI], u32x4 (&rb)[4],
                      bool chained_in, const bf16_t* An, const bf16_t* Bn, bool has_next) {
    const int tid = threadIdx.x, lane = tid & 63, wave = tid >> 6, wm = wave >> 2, wn = wave & 3, l32 = lane & 31, hi = lane >> 5;
    const int r0 = tid >> 3, c8 = tid & 7;
    const int nt = K / 64;
    const int woff = r0 * 128 + ((c8 ^ ((r0 >> 1) & 7)) * 16);
#define G_LOAD(kt) do { const bf16_t* ap_ = ((kt) < nt) ? Aptr + (kt) * 64 : An + ((kt) - nt) * 64; const bf16_t* bp_ = ((kt) < nt) ? Bt + (kt) * 64 : Bn + ((kt) - nt) * 64; \
        _Pragma("unroll") for (int i = 0; i < MI; ++i) ra[i] = *(const u32x4*)(ap_ + (size_t)(r0 + 64 * i) * lda + c8 * 8); \
        _Pragma("unroll") for (int i = 0; i < 4; ++i) rb[i] = *(const u32x4*)(bp_ + (size_t)(r0 + 64 * i) * ldb + c8 * 8); } while (0)
#define G_LOAD_A(kt) do { const bf16_t* ap_ = ((kt) < nt) ? Aptr + (kt) * 64 : An + ((kt) - nt) * 64; \
        _Pragma("unroll") for (int i = 0; i < MI; ++i) ra[i] = *(const u32x4*)(ap_ + (size_t)(r0 + 64 * i) * lda + c8 * 8); } while (0)
#define G_LOAD_B(kt) do { const bf16_t* bp_ = ((kt) < nt) ? Bt + (kt) * 64 : Bn + ((kt) - nt) * 64; \
        _Pragma("unroll") for (int i = 0; i < 4; ++i) rb[i] = *(const u32x4*)(bp_ + (size_t)(r0 + 64 * i) * ldb + c8 * 8); } while (0)
#define G_STORE_A(buf) do { _Pragma("unroll") for (int i = 0; i < MI; ++i) *(u32x4*)(lds + (buf) * GSTG + i * 8192 + woff) = ra[i]; } while (0)
#define G_STORE_B(buf) do { _Pragma("unroll") for (int i = 0; i < 4; ++i) *(u32x4*)(lds + (buf) * GSTG + 32768 + i * 8192 + woff) = rb[i]; } while (0)
#define G_RD(f, s) do { fb[f][0] = *(const bf16x8*)(Bs + offs[s]); fb[f][1] = *(const bf16x8*)(Bs + 32 * 128 + offs[s]); \
        _Pragma("unroll") for (int mi = 0; mi < MI; ++mi) fa[f][mi] = *(const bf16x8*)(As + mi * 32 * 128 + offs[s]); } while (0)
#define G_MMA(f) do { _Pragma("unroll") for (int mi = 0; mi < MI; ++mi) { \
            acc[mi][0] = mfma32(fb[f][0], fa[f][mi], acc[mi][0]); acc[mi][1] = mfma32(fb[f][1], fa[f][mi], acc[mi][1]); } } while (0)
#define G_FENCE() __builtin_amdgcn_sched_barrier(0)
    if (!chained_in) { G_LOAD(0); G_STORE_A(0); G_STORE_B(0); G_LOAD(1); __syncthreads(); }
    const int rsw = (l32 >> 1) & 7;
    int offs[4];
#pragma unroll
    for (int s = 0; s < 4; ++s) offs[s] = l32 * 128 + (((2 * s + hi) ^ rsw) * 16);
    bf16x8 fa[2][MI], fb[2][2];
    for (int t = 0; t < nt; ++t) {
        const char* As = lds + (t & 1) * GSTG + (wm * 32 * MI) * 128;
        const char* Bs = lds + (t & 1) * GSTG + 32768 + (wn * 64) * 128;
        const bool st = (t + 1 < nt) || has_next, ld = (t + 2 < nt) || has_next;
        G_RD(0, 0); G_RD(1, 1);
        G_FENCE();
        G_MMA(0);
        G_FENCE();
        if (st) G_STORE_A((t + 1) & 1);
        if (MI == 3 && ld) G_LOAD_A(t + 2);
        G_RD(0, 2);
        G_FENCE();
        G_MMA(1);
        G_FENCE();
        if (st) G_STORE_B((t + 1) & 1);
        if (MI != 3 && ld) G_LOAD_A(t + 2);
        if (ld) G_LOAD_B(t + 2);
        G_RD(1, 3);
        G_FENCE();
        G_MMA(0);
        G_FENCE();
        G_MMA(1);
        G_FENCE();
        __syncthreads();
    }
#undef G_RD
#undef G_FENCE
#undef G_STORE_A
#undef G_STORE_B
#undef G_MMA
#undef G_LOAD
#undef G_LOAD_A
#undef G_LOAD_B
}

template <int MI>
DI void gemm_preload(u32x4 (&ra)[MI], u32x4 (&rb)[4], const bf16_t* Aptr, int lda, const bf16_t* Bt, int ldb) {
    const int r0 = threadIdx.x >> 3, c8 = threadIdx.x & 7;
#pragma unroll
    for (int i = 0; i < MI; ++i) ra[i] = *(const u32x4*)(Aptr + (size_t)(r0 + 64 * i) * lda + c8 * 8);
#pragma unroll
    for (int i = 0; i < 4; ++i) rb[i] = *(const u32x4*)(Bt + (size_t)(r0 + 64 * i) * ldb + c8 * 8);
}

template <int MI>
DI void zero_acc(f32x16 (&acc)[MI][2]) {
#pragma unroll
    for (int a = 0; a < MI; ++a)
#pragma unroll
        for (int b = 0; b < 2; ++b)
#pragma unroll
            for (int r = 0; r < 16; ++r) acc[a][b][r] = 0.f;
}

DI float rstd_of(const float* ssq, int row) { return 1.0f / sqrtf(ssq[row] * (1.0f / D) + EPS); }

template <int MI>
DI void store_resid(const f32x16 (&acc)[MI][2], int m0, int n0, float* H, bf16_t* hb, float* ssq_out) {
    const int tid = threadIdx.x, lane = tid & 63, wave = tid >> 6, wm = wave >> 2, wn = wave & 3, l32 = lane & 31, hi = lane >> 5;
#pragma unroll
    for (int mi = 0; mi < MI; ++mi) {
        const int row = m0 + 32 * MI * wm + 32 * mi + l32;
        float ss = 0.f;
#pragma unroll
        for (int ni = 0; ni < 2; ++ni)
#pragma unroll
            for (int g4 = 0; g4 < 4; ++g4) {
                const int col = n0 + 64 * wn + 32 * ni + 8 * g4 + 4 * hi;
                const f32x4 v = {acc[mi][ni][4 * g4], acc[mi][ni][4 * g4 + 1], acc[mi][ni][4 * g4 + 2], acc[mi][ni][4 * g4 + 3]};
                *(f32x4*)(H + (size_t)row * D + col) = v;
                if (hb) *(u32x2*)(hb + (size_t)row * D + col) = (u32x2){cvtpk(v[0], v[1]), cvtpk(v[2], v[3])};
                ss += (v[0] * v[0] + v[1] * v[1]) + (v[2] * v[2] + v[3] * v[3]);
            }
        ss += __shfl_xor(ss, 32);
        if (hi == 0) atomicAdd(ssq_out + row, ss);
    }
}

enum { E_INPROJ0 = 1, E_OUT = 3, E_GU = 4, E_DOWN = 5, E_PE = 6, E_INPROJ1 = 7 };

template <int EPI, int MI>
DI void gemm_phase(const Params& p, int layer, char* lds) {
    unsigned char* ws = p.ws;
    const int tid = threadIdx.x, lane = tid & 63, wave = tid >> 6, wm = wave >> 2, wn = wave & 3, l32 = lane & 31, hi = lane >> 5;
    constexpr int BM = 64 * MI, WR = 32 * MI;
    float* H = p.out;
    float* ssq = (float*)(ws + WS_SSQ);
    bf16_t* hb0 = (bf16_t*)(ws + WS_HB0); bf16_t* hb1 = (bf16_t*)(ws + WS_HB1);
    int N, K; const bf16_t* A; const bf16_t* Bt;
    if (EPI == E_INPROJ0) { N = 3072; K = 1024; A = hb1; Bt = (const bf16_t*)(ws + W_AB_IN); }
    if (EPI == E_OUT) { N = 1024; K = 1024; A = (const bf16_t*)(ws + WS_Q); Bt = (const bf16_t*)(ws + (layer ? W_C_OUT : W_AB_OUT)); }
    if (EPI == E_GU) { N = 5632; K = 1024; A = layer ? hb1 : hb0; Bt = (const bf16_t*)(ws + W_GU) + (size_t)layer * 5632 * 1024; }
    if (EPI == E_DOWN) { N = 1024; K = DFF; A = (const bf16_t*)(ws + WS_ACT); Bt = (const bf16_t*)(ws + W_DN) + (size_t)layer * 1024 * DFF; }
    if (EPI == E_PE) { N = 1024; K = 1024; A = layer ? hb0 : hb1; Bt = (const bf16_t*)(ws + W_PG) + (size_t)layer * 1024 * 1024; }
    if (EPI == E_INPROJ1) { N = 1536; K = 1024; A = hb0; Bt = (const bf16_t*)(ws + W_C_IN); }
    const int ntn = N / 256, MT = M / BM, Gd = gridDim.x;
    const int nx = (Gd % 8 == 0) ? 8 : 1, xcd = (nx == 8) ? (int)(blockIdx.x & 7) : 0, local = (nx == 8) ? (int)(blockIdx.x >> 3) : (int)blockIdx.x, nl = Gd / nx;
    const int m_lo = (xcd * MT) / nx, mtx = ((xcd + 1) * MT) / nx - m_lo;
    const int GM = (ntn >= 8) ? 4 : 8;
    u32x4 ra[MI], rb[4];
    int m0 = 0, n0 = 0;
#define TILE_MN(jj, mm, nn) do { const int g_ = (jj) / (GM * ntn), within_ = (jj) - g_ * GM * ntn, fm_ = g_ * GM, gsz_ = min(GM, mtx - fm_); \
        mm = (m_lo + fm_ + within_ % gsz_) * BM; nn = (within_ / gsz_) * 256; } while (0)
    if (local < mtx * ntn) TILE_MN(local, m0, n0);
    bool chained = false;
    for (int j = local; j < mtx * ntn; j += nl) {
        f32x16 acc[MI][2];
        zero_acc<MI>(acc);
        const int cm0 = m0, cn0 = n0;
        const bool has_next = (EPI != E_PE) && (j + nl < mtx * ntn);
        if (j + nl < mtx * ntn) TILE_MN(j + nl, m0, n0);
        gemm_mainloop<MI>(acc, A + (size_t)cm0 * K, K, Bt + (size_t)cn0 * K, K, K, lds, ra, rb, chained, A + (size_t)m0 * K, Bt + (size_t)n0 * K, has_next);
        chained = has_next;
        if constexpr (EPI == E_INPROJ0) {
            const int tt = cn0 / 512;
            bf16_t* Q = (bf16_t*)(ws + WS_Q);
#pragma unroll
            for (int mi = 0; mi < MI; ++mi) {
                const int row = cm0 + WR * wm + 32 * mi + l32;
                const float rs = rstd_of(ssq, row);
                const bool pr = row < MP;
                const int sb_ = (row - MP) >> 6, st_ = (row - MP) & 63;
                float kss = 0.f;
#pragma unroll
                for (int ni = 0; ni < 2; ++ni)
#pragma unroll
                    for (int g4 = 0; g4 < 4; ++g4) {
                        const int col = cn0 + 64 * wn + 32 * ni + 8 * g4 + 4 * hi, cseg = col - tt * 512;
                        f32x4 v = {acc[mi][ni][4 * g4], acc[mi][ni][4 * g4 + 1], acc[mi][ni][4 * g4 + 2], acc[mi][ni][4 * g4 + 3]};
                        v = v * rs;
                        if (tt == 0 || tt == 3) {
                            v = v * QS;
                            *(u32x2*)(Q + (size_t)row * 1024 + (tt == 3 ? 512 : 0) + cseg) = (u32x2){cvtpk(v[0], v[1]), cvtpk(v[2], v[3])};
                        } else {
                            const int type = tt >= 3;
                            const bool isk = (tt == 1 || tt == 4);
                            size_t oo;
                            if (isk) oo = pr ? (type ? O_PS_K : O_PF_K) : (type ? O_SS_K : O_SF_K); else oo = pr ? (type ? O_PS_V : O_PF_V) : (type ? O_SS_V : O_SF_V);
                            *(f32x4*)(p.out + oo + (size_t)(pr ? row : row - MP) * 512 + cseg) = v;
                            if (isk) {
                                kss += (v[0] * v[0] + v[1] * v[1]) + (v[2] * v[2] + v[3] * v[3]);
                                bf16_t* kd = pr ? (bf16_t*)(ws + WS_KP) + (size_t)row * 1024 : (bf16_t*)(ws + WS_KS) + (size_t)(sb_ * TS + PAST + st_) * 1024;
                                *(u32x2*)(kd + type * 512 + cseg) = (u32x2){cvtpk(v[0], v[1]), cvtpk(v[2], v[3])};
                            } else {
                                const int head = cseg >> 6, d = cseg & 63;
                                bf16_t* vd; size_t ldv; int t;
                                if (pr) { const int b = row >> 14; t = row & (S - 1); ldv = S; vd = (bf16_t*)(ws + WS_VTP) + ((size_t)((type * 2 + b) * 8 + head) * 64 + d) * S; }
                                else { t = PAST + st_; ldv = TS; vd = (bf16_t*)(ws + WS_VTS) + ((size_t)((type * 16 + sb_) * 8 + head) * 64 + d) * TS; }
                                const int pos = (t & ~63) | permkv(t & 63);
                                const unsigned w01 = cvtpk(v[0], v[1]), w23 = cvtpk(v[2], v[3]);
                                vd[pos] = (bf16_t)(w01 & 0xffff); vd[ldv + pos] = (bf16_t)(w01 >> 16); vd[2 * ldv + pos] = (bf16_t)(w23 & 0xffff); vd[3 * ldv + pos] = (bf16_t)(w23 >> 16);
                            }
                        }
                    }
                if (tt == 1) {
                    kss += __shfl_xor(kss, 32);
#pragma unroll
                    for (int o = 1; o < 32; o <<= 1) kss = fmaxf(kss, __shfl_xor(kss, o));
                    const int head = (cn0 + 64 * wn - 512) >> 6;
                    if (lane == 0) atomicMax((unsigned*)(ws + WS_KMAX) + (pr ? (row >> 14) * 8 + head : 16 + sb_ * 8 + head), __float_as_uint(kss));
                }
            }
        }
        if constexpr (EPI == E_INPROJ1) {
            bf16_t* Q = (bf16_t*)(ws + WS_Q);
            const float* rope = (const float*)(ws + WS_ROPE);
            const int tt = cn0 < 1024 ? 0 : (cn0 < 1280 ? 1 : 2);
#pragma unroll
            for (int mi = 0; mi < MI; ++mi) {
                const int row = cm0 + WR * wm + 32 * mi + l32;
                const float rs = rstd_of(ssq + 3 * M, row);
                const bool pr = row < MP;
                const int sb_ = (row - MP) >> 6, st_ = (row - MP) & 63;
                const int pos = pr ? (row & (S - 1)) : PAST + st_;
                if (tt < 2) {
                    const f32x4 cs0 = *(const f32x4*)(rope + (size_t)pos * 16 + 8 * hi), cs1 = *(const f32x4*)(rope + (size_t)pos * 16 + 8 * hi + 4);
                    const float cc[4] = {cs0[0], cs0[2], cs1[0], cs1[2]}, sn[4] = {cs0[1], cs0[3], cs1[1], cs1[3]};
#pragma unroll
                    for (int e = 0; e < 4; ++e) { const float x1 = acc[mi][0][e], x2 = acc[mi][0][4 + e]; acc[mi][0][e] = x1 * cc[e] - x2 * sn[e]; acc[mi][0][4 + e] = x2 * cc[e] + x1 * sn[e]; }
                }
#pragma unroll
                for (int ni = 0; ni < 2; ++ni)
#pragma unroll
                    for (int g4 = 0; g4 < 4; ++g4) {
                        const int col = cn0 + 64 * wn + 32 * ni + 8 * g4 + 4 * hi;
                        f32x4 v = {acc[mi][ni][4 * g4], acc[mi][ni][4 * g4 + 1], acc[mi][ni][4 * g4 + 2], acc[mi][ni][4 * g4 + 3]};
                        v = v * rs;
                        if (tt == 0) { v = v * QS; *(u32x2*)(Q + (size_t)row * 1024 + col) = (u32x2){cvtpk(v[0], v[1]), cvtpk(v[2], v[3])}; }
                        else {
                            const int cseg = col - (tt == 1 ? 1024 : 1280);
                            if (pr) { const int t = row & (S - 1), b = row >> 14; if (t >= S - 128) *(f32x4*)(p.out + (tt == 1 ? O_PW_K : O_PW_V) + (size_t)(b * 128 + t - (S - 128)) * 256 + cseg) = v; }
                            else *(f32x4*)(p.out + (tt == 1 ? O_SW_K : O_SW_V) + (size_t)(sb_ * 128 + 64 + st_) * 256 + cseg) = v;
                            if (tt == 1) {
                                bf16_t* kd = pr ? (bf16_t*)(ws + WS_K1P) + (size_t)row * 256 : (bf16_t*)(ws + WS_K1S) + (size_t)(sb_ * 192 + 128 + st_) * 256;
                                *(u32x2*)(kd + cseg) = (u32x2){cvtpk(v[0], v[1]), cvtpk(v[2], v[3])};
                            } else {
                                const int head = cseg >> 6, d = cseg & 63;
                                bf16_t* vd; size_t ldv; int t;
                                if (pr) { const int b = row >> 14; t = row & (S - 1); ldv = S; vd = (bf16_t*)(ws + WS_VT1P) + ((size_t)(b * 4 + head) * 64 + d) * S; }
                                else { t = 128 + st_; ldv = 192; vd = (bf16_t*)(ws + WS_VT1S) + ((size_t)(sb_ * 4 + head) * 64 + d) * 192; }
                                const int ps = (t & ~63) | permkv(t & 63);
                                const unsigned w01 = cvtpk(v[0], v[1]), w23 = cvtpk(v[2], v[3]);
                                vd[ps] = (bf16_t)(w01 & 0xffff); vd[ldv + ps] = (bf16_t)(w01 >> 16); vd[2 * ldv + ps] = (bf16_t)(w23 & 0xffff); vd[3 * ldv + ps] = (bf16_t)(w23 >> 16);
                            }
                        }
                    }
            }
        }
        if constexpr (EPI == E_OUT) {
#pragma unroll
            for (int mi = 0; mi < MI; ++mi) {
                const int row = cm0 + WR * wm + 32 * mi + l32;
                const float* res = layer ? H + (size_t)row * D : (row < MP ? p.in[0] + (size_t)row * D : p.in[1] + (size_t)(row - MP) * D);
#pragma unroll
                for (int ni = 0; ni < 2; ++ni)
#pragma unroll
                    for (int g4 = 0; g4 < 4; ++g4) {
                        const int col = cn0 + 64 * wn + 32 * ni + 8 * g4 + 4 * hi;
                        const f32x4 r = *(const f32x4*)(res + col);
#pragma unroll
                        for (int e = 0; e < 4; ++e) acc[mi][ni][4 * g4 + e] += r[e];
                    }
            }
            store_resid<MI>(acc, cm0, cn0, H, layer ? hb1 : hb0, ssq + (size_t)(layer ? 4 : 1) * M);
        }
        if constexpr (EPI == E_GU) {
            bf16_t* act = (bf16_t*)(ws + WS_ACT);
            const float* sq = ssq + (size_t)(layer ? 4 : 1) * M;
#pragma unroll
            for (int mi = 0; mi < MI; ++mi) {
                const int row = cm0 + WR * wm + 32 * mi + l32;
                const float rs = rstd_of(sq, row);
#pragma unroll
                for (int g4 = 0; g4 < 4; ++g4) {
                    const int col = (cn0 >> 1) + 32 * wn + 8 * g4 + 4 * hi;
                    float o[4];
#pragma unroll
                    for (int e = 0; e < 4; ++e) { const float g = acc[mi][0][4 * g4 + e] * rs, u = acc[mi][1][4 * g4 + e] * rs; o[e] = g * fast_rcp(1.f + fast_exp2(-g * LOG2E)) * u; }
                    *(u32x2*)(act + (size_t)row * DFF + col) = (u32x2){cvtpk(o[0], o[1]), cvtpk(o[2], o[3])};
                }
            }
        }
        if constexpr (EPI == E_DOWN) {
#pragma unroll
            for (int mi = 0; mi < MI; ++mi) {
                const int row = cm0 + WR * wm + 32 * mi + l32;
#pragma unroll
                for (int ni = 0; ni < 2; ++ni)
#pragma unroll
                    for (int g4 = 0; g4 < 4; ++g4) {
                        const int col = cn0 + 64 * wn + 32 * ni + 8 * g4 + 4 * hi;
                        const f32x4 r = *(const f32x4*)(H + (size_t)row * D + col);
#pragma unroll
                        for (int e = 0; e < 4; ++e) acc[mi][ni][4 * g4 + e] += r[e];
                    }
            }
            store_resid<MI>(acc, cm0, cn0, H, layer ? hb0 : hb1, ssq + (size_t)(layer ? 5 : 2) * M);
        }
        if constexpr (EPI == E_PE) {
            f32x16 acp[MI][2];
            zero_acc<MI>(acp);
            gemm_mainloop<MI>(acp, (const bf16_t*)(ws + WS_PB) + ((size_t)layer * M + cm0) * PE, PE, (const bf16_t*)(ws + W_PP) + (size_t)layer * 1024 * 256 + (size_t)cn0 * 256, 256, 256, lds, ra, rb, false, nullptr, nullptr, false);
            const float* sq = ssq + (size_t)(layer ? 5 : 2) * M;
#pragma unroll
            for (int mi = 0; mi < MI; ++mi) {
                const int row = cm0 + WR * wm + 32 * mi + l32;
                const float rs = rstd_of(sq, row);
#pragma unroll
                for (int ni = 0; ni < 2; ++ni)
#pragma unroll
                    for (int g4 = 0; g4 < 4; ++g4) {
                        const int col = cn0 + 64 * wn + 32 * ni + 8 * g4 + 4 * hi;
                        const f32x4 r = *(const f32x4*)(H + (size_t)row * D + col);
#pragma unroll
                        for (int e = 0; e < 4; ++e) { const float gl = acc[mi][ni][4 * g4 + e] * rs; acc[mi][ni][4 * g4 + e] = r[e] + acp[mi][ni][4 * g4 + e] * fast_rcp(1.f + fast_exp2(-gl * LOG2E)); }
                    }
            }
            store_resid<MI>(acc, cm0, cn0, H, layer ? nullptr : hb0, ssq + (size_t)(layer ? 6 : 3) * M);
        }
    }
}

template <int MODE, bool CF = false>
DI void attn_item(const bf16_t* Qw, bf16_t* Ow, int qpos0, bool active, const bf16_t* Kb, int ldk, const bf16_t* Vb, int ldv, const float* cb,
                  int kt_hi, int kt_lo, float sink2, float kmax, char* lds, const float* Kc = nullptr, const float* Vc = nullptr, int ktc = 0) {
    const int tid = threadIdx.x, lane = tid & 63, wave = tid >> 6, l32 = lane & 31, hi = lane >> 5;
    const int r0 = tid >> 3, c8 = tid & 7;
    bf16x8 qf[4];
#pragma unroll
    for (int ks = 0; ks < 4; ++ks) qf[ks] = active ? *(const bf16x8*)(Qw + (size_t)l32 * 1024 + ks * 16 + hi * 8) : (bf16x8){0, 0, 0, 0, 0, 0, 0, 0};
    float m = (MODE == 2) ? sink2 : NEGBIG;
    float l = (MODE == 2 && hi == 0) ? 1.f : 0.f;
    float R = 1.f;
    float bq = 0.f;
    if (MODE == 0) {
        float qq = 0.f;
#pragma unroll
        for (int ks = 0; ks < 4; ++ks)
#pragma unroll
            for (int j = 0; j < 8; ++j) { const float f = __uint_as_float(((unsigned)(unsigned short)qf[ks][j]) << 16); qq += f * f; }
        qq += __shfl_xor(qq, 32);
        bq = sqrtf(qq) * kmax;
    }
    f32x16 o0, o1;
#pragma unroll
    for (int r = 0; r < 16; ++r) { o0[r] = 0.f; o1[r] = 0.f; }
    volatile int* flags = (volatile int*)(lds + 2 * ASTG);
    u32x4 rk, rv; f32x4 rc = {0.f, 0.f, 0.f, 0.f};
    f32x4 fk0, fk1, fv0, fv1; bool stf = false;
#define A_LOAD(kt) do { \
        if (CF && (kt) < ktc) { const float* kp_ = Kc + (size_t)((kt) * 64 + lane) * 512 + wave * 8; const float* vp_ = Vc + (size_t)((kt) * 64 + lane) * 512 + wave * 8; \
            fk0 = *(const f32x4*)kp_; fk1 = *(const f32x4*)(kp_ + 4); fv0 = *(const f32x4*)vp_; fv1 = *(const f32x4*)(vp_ + 4); stf = true; } \
        else { rk = *(const u32x4*)(Kb + (size_t)((kt) * 64 + r0) * ldk + c8 * 8); \
            rv = *(const u32x4*)(Vb + (size_t)r0 * ldv + (kt) * 64 + c8 * 8); stf = false; } \
        if (MODE == 0 && tid < 16) rc = *(const f32x4*)(cb + (kt) * 64 + tid * 4); } while (0)
#define A_STORE(st) do { \
        if (CF && stf) { \
            *(u32x4*)(lds + (st) * ASTG + lane * PITCH + wave * 16) = (u32x4){cvtpk(fk0[0], fk0[1]), cvtpk(fk0[2], fk0[3]), cvtpk(fk1[0], fk1[1]), cvtpk(fk1[2], fk1[3])}; \
            bf16_t* vt_ = (bf16_t*)(lds + (st) * ASTG + 64 * PITCH) + (wave * 8) * (PITCH / 2) + permkv(lane); \
            const unsigned w0_ = cvtpk(fv0[0], fv0[1]), w1_ = cvtpk(fv0[2], fv0[3]), w2_ = cvtpk(fv1[0], fv1[1]), w3_ = cvtpk(fv1[2], fv1[3]); \
            vt_[0] = (bf16_t)(w0_ & 0xffff); vt_[PITCH / 2] = (bf16_t)(w0_ >> 16); vt_[2 * (PITCH / 2)] = (bf16_t)(w1_ & 0xffff); vt_[3 * (PITCH / 2)] = (bf16_t)(w1_ >> 16); \
            vt_[4 * (PITCH / 2)] = (bf16_t)(w2_ & 0xffff); vt_[5 * (PITCH / 2)] = (bf16_t)(w2_ >> 16); vt_[6 * (PITCH / 2)] = (bf16_t)(w3_ & 0xffff); vt_[7 * (PITCH / 2)] = (bf16_t)(w3_ >> 16); } \
        else { *(u32x4*)(lds + (st) * ASTG + r0 * PITCH + c8 * 16) = rk; \
            *(u32x4*)(lds + (st) * ASTG + 64 * PITCH + r0 * PITCH + c8 * 16) = rv; } \
        if (MODE == 0 && tid < 16) *(f32x4*)(lds + (st) * ASTG + 128 * PITCH + tid * 16) = rc; } while (0)
    A_LOAD(kt_hi); A_STORE(0);
    if (kt_hi > kt_lo) A_LOAD(kt_hi - 1);
    __syncthreads();
    const int qp = qpos0 + l32;
    int it = 0;
    for (int kt = kt_hi; kt >= kt_lo; --kt, ++it) {
        const int st = it & 1;
        if (kt > kt_lo) A_STORE(st ^ 1);
        if (kt > kt_lo + 1) A_LOAD(kt - 2);
        __builtin_amdgcn_sched_barrier(0);
        const int ts = kt * 64;
        bool skip = !active;
        bool lane_alive = true;
        if (MODE == 0) skip = skip || (ts > qpos0 + 31);
        if (MODE == 1) skip = skip || (ts >= qpos0 + 31);
        if (!skip) {
            const char* Ks = lds + st * ASTG + l32 * PITCH + hi * 16;
            const char* Vs = lds + st * ASTG + 64 * PITCH + l32 * PITCH + hi * 16;
            f32x16 s0, s1;
#pragma unroll
            for (int r = 0; r < 16; ++r) { s0[r] = 0.f; s1[r] = 0.f; }
#pragma unroll
            for (int ks = 0; ks < 4; ++ks) {
                const bf16x8 k0 = *(const bf16x8*)(Ks + ks * 32), k1 = *(const bf16x8*)(Ks + 32 * PITCH + ks * 32);
                s0 = mfma32(k0, qf[ks], s0); s1 = mfma32(k1, qf[ks], s1);
            }
            if (MODE == 0) {
                const float* cbs = (const float*)(lds + st * ASTG + 128 * PITCH);
#pragma unroll
                for (int g4 = 0; g4 < 4; ++g4) {
                    const f32x4 c0 = *(const f32x4*)(cbs + 8 * g4 + 4 * hi), c1 = *(const f32x4*)(cbs + 32 + 8 * g4 + 4 * hi);
#pragma unroll
                    for (int e = 0; e < 4; ++e) { s0[4 * g4 + e] -= c0[e]; s1[4 * g4 + e] -= c1[e]; }
                }
            }
            if (MODE != 1) {
                if (MODE == 0 && ts + 63 > qpos0) {
#pragma unroll
                    for (int r = 0; r < 16; ++r) { const int kv = ts + crow(r, hi); if (kv > qp) s0[r] = NEGBIG; if (kv + 32 > qp) s1[r] = NEGBIG; }
                }
                float mx;
                if (MODE == 0) {
                    mx = max3f(s0[0], s1[0], s0[1]);
                    mx = max3f(mx, s1[1], s0[2]);
#pragma unroll
                    for (int r = 2; r < 15; ++r) mx = max3f(mx, s1[r], s0[r + 1]);
                    mx = fmaxf(mx, s1[15]);
                } else {
                    mx = fmaxf(s0[0], s1[0]);
#pragma unroll
                    for (int r = 1; r < 16; ++r) mx = fmaxf(mx, fmaxf(s0[r], s1[r]));
                }
                mx = fmaxf(mx, __shfl_xor(mx, 32));
                const float mn = fmaxf(m, mx);
                if (__any(mn > m)) {
                    const float al = fast_exp2(m - mn);
                    l *= al;
#pragma unroll
                    for (int r = 0; r < 16; ++r) { o0[r] *= al; o1[r] *= al; }
                    m = mn;
                }
                float ls = 0.f;
#pragma unroll
                for (int r = 0; r < 16; ++r) { s0[r] = fast_exp2(s0[r] - m); s1[r] = fast_exp2(s1[r] - m); ls += s0[r] + s1[r]; }
                l += ls;
                if (MODE == 0) {
                    const float cb0 = *(const float*)(lds + st * ASTG + 128 * PITCH);
                    lane_alive = !((bq - cb0) - m < -152.f);
                }
            } else {
                const bool diag = (ts + 63 >= qpos0);
                f32x16 m0_, m1_;
#pragma unroll
                for (int r = 0; r < 16; ++r) {
                    {
                        const float z = s0[r], e = fast_exp2(-fabsf(z)), rr = fast_rcp(1.f + e), er = e * rr;
                        float sg = z > 0.f ? rr : er, om = z > 0.f ? er : rr;
                        if (diag && !(ts + crow(r, hi) < qp)) { sg = 0.f; om = 1.f; }
                        s0[r] = sg; m0_[r] = om;
                    }
                    {
                        const float z = s1[r], e = fast_exp2(-fabsf(z)), rr = fast_rcp(1.f + e), er = e * rr;
                        float sg = z > 0.f ? rr : er, om = z > 0.f ? er : rr;
                        if (diag && !(ts + 32 + crow(r, hi) < qp)) { sg = 0.f; om = 1.f; }
                        s1[r] = sg; m1_[r] = om;
                    }
                }
                float run = R;
#pragma unroll
                for (int a = 1; a >= 0; --a)
#pragma unroll
                    for (int g4 = 3; g4 >= 0; --g4) {
                        const float om0 = a ? m1_[4 * g4] : m0_[4 * g4], om1 = a ? m1_[4 * g4 + 1] : m0_[4 * g4 + 1], om2 = a ? m1_[4 * g4 + 2] : m0_[4 * g4 + 2], om3 = a ? m1_[4 * g4 + 3] : m0_[4 * g4 + 3];
                        const float G = (om0 * om1) * (om2 * om3);
                        const float PG = __shfl_xor(G, 32);
                        const float b3 = hi ? run : run * PG;
                        const float b2 = b3 * om3, b1 = b2 * om2, b0 = b1 * om1;
                        if (a) { s1[4 * g4] *= b0; s1[4 * g4 + 1] *= b1; s1[4 * g4 + 2] *= b2; s1[4 * g4 + 3] *= b3; }
                        else { s0[4 * g4] *= b0; s0[4 * g4 + 1] *= b1; s0[4 * g4 + 2] *= b2; s0[4 * g4 + 3] *= b3; }
                        run = run * (G * PG);
                    }
                R = run;
            }
            bf16x8 pf[2][2];
#pragma unroll
            for (int sp = 0; sp < 2; ++sp) {
                pf[0][sp] = __builtin_bit_cast(bf16x8, (u32x4){cvtpk(s0[8 * sp], s0[8 * sp + 1]), cvtpk(s0[8 * sp + 2], s0[8 * sp + 3]), cvtpk(s0[8 * sp + 4], s0[8 * sp + 5]), cvtpk(s0[8 * sp + 6], s0[8 * sp + 7])});
                pf[1][sp] = __builtin_bit_cast(bf16x8, (u32x4){cvtpk(s1[8 * sp], s1[8 * sp + 1]), cvtpk(s1[8 * sp + 2], s1[8 * sp + 3]), cvtpk(s1[8 * sp + 4], s1[8 * sp + 5]), cvtpk(s1[8 * sp + 6], s1[8 * sp + 7])});
            }
#pragma unroll
            for (int a = 0; a < 2; ++a)
#pragma unroll
                for (int sp = 0; sp < 2; ++sp) {
                    const bf16x8 v0 = *(const bf16x8*)(Vs + (a * 32 + sp * 16) * 2), v1 = *(const bf16x8*)(Vs + 32 * PITCH + (a * 32 + sp * 16) * 2);
                    o0 = mfma32(v0, pf[a][sp], o0); o1 = mfma32(v1, pf[a][sp], o1);
                }
        }
        __builtin_amdgcn_sched_barrier(0);
        if (MODE <= 1) { const int alive = (active && (MODE == 1 ? __any(R > 0.f) : (skip || __any(lane_alive)))) ? 1 : 0; if (lane == 0) flags[st * 8 + wave] = alive; }
        __syncthreads();
        if (MODE <= 1) { int any = 0;
#pragma unroll
            for (int w = 0; w < 8; ++w) any |= flags[st * 8 + w];
            if (any == 0) break; }
    }
#undef A_LOAD
#undef A_STORE
    if (active) {
        float inv = 1.f;
        if (MODE != 1) { const float lt = l + __shfl_xor(l, 32); inv = 1.0f / lt; }
#pragma unroll
        for (int g4 = 0; g4 < 4; ++g4) {
            *(u32x2*)(Ow + (size_t)l32 * 1024 + 8 * g4 + 4 * hi) = (u32x2){cvtpk(o0[4 * g4] * inv, o0[4 * g4 + 1] * inv), cvtpk(o0[4 * g4 + 2] * inv, o0[4 * g4 + 3] * inv)};
            *(u32x2*)(Ow + (size_t)l32 * 1024 + 32 + 8 * g4 + 4 * hi) = (u32x2){cvtpk(o1[4 * g4] * inv, o1[4 * g4 + 1] * inv), cvtpk(o1[4 * g4 + 2] * inv, o1[4 * g4 + 3] * inv)};
        }
    }
    __syncthreads();
}

template <int MODE>
DI void ab_prompt_item(const Params& p, int bh, int qb, char* lds) {
    const int wave = threadIdx.x >> 6;
    const int b = bh >> 3, h = bh & 7;
    bf16_t* Q = (bf16_t*)(p.ws + WS_Q);
    const size_t row0 = (size_t)b * S + qb * 256 + 32 * wave;
    const int colq = MODE * 512 + h * 64;
    const bf16_t* Kb = (const bf16_t*)(p.ws + WS_KP) + (size_t)b * S * 1024 + colq;
    const bf16_t* Vb = (const bf16_t*)(p.ws + WS_VTP) + (size_t)((MODE * 2 + b) * 8 + h) * 64 * S;
    const float* cb = (const float*)(p.ws + WS_C2P) + (size_t)bh * S;
    attn_item<MODE>(Q + row0 * 1024 + colq, Q + row0 * 1024 + colq, qb * 256 + 32 * wave, true, Kb, 1024, Vb, S, cb, 4 * qb + 3, 0, 0.f, MODE == 0 ? sqrtf(__uint_as_float(((const unsigned*)(p.ws + WS_KMAX))[bh])) * 1.004f : 0.f, lds);
}
template <int MODE>
DI void ab_sample_item(const Params& p, int bh, char* lds) {
    const int wave = threadIdx.x >> 6;
    const int b = bh >> 3, h = bh & 7;
    bf16_t* Q = (bf16_t*)(p.ws + WS_Q);
    const int wv = wave & 1;
    const size_t row0 = (size_t)MP + b * 64 + 32 * wv;
    const int colq = MODE * 512 + h * 64;
    const bf16_t* Kb = (const bf16_t*)(p.ws + WS_KS) + (size_t)b * TS * 1024 + colq;
    const bf16_t* Vb = (const bf16_t*)(p.ws + WS_VTS) + (size_t)((MODE * 16 + b) * 8 + h) * 64 * TS;
    const float* cb = (const float*)(p.ws + WS_C2S) + (size_t)bh * TS;
    attn_item<MODE, true>(Q + row0 * 1024 + colq, Q + row0 * 1024 + colq, PAST + 32 * wv, wave < 2, Kb, 1024, Vb, TS, cb, 32, 0, 0.f, MODE == 0 ? sqrtf(__uint_as_float(((const unsigned*)(p.ws + WS_KMAX))[16 + bh])) * 1.004f : 0.f, lds,
                          p.in[MODE ? 5 : 2] + (size_t)b * PAST * 512 + h * 64, p.in[MODE ? 6 : 3] + (size_t)b * PAST * 512 + h * 64, 32);
}

DI void phase_attn0(const Params& p, char* lds) {
    const int G = gridDim.x, j = blockIdx.x;
    for (int k = 0; k * G < 1024; ++k) {
        const int rank = k * G + ((k & 1) ? G - 1 - j : j);
        if (rank >= 1024) continue;
        ab_prompt_item<0>(p, rank & 15, 63 - (rank >> 4), lds);
    }
    for (int i = G - 1 - j; i < 128 + 128 + 1024; i += G) {
        if (i < 128) ab_sample_item<0>(p, i, lds);
        else if (i < 256) ab_sample_item<1>(p, i - 128, lds);
        else { const int r = i - 256; ab_prompt_item<1>(p, r & 15, r >> 4, lds); }
    }
}

DI void phase_attn1(const Params& p, char* lds) {
    const int wave = threadIdx.x >> 6;
    bf16_t* Q = (bf16_t*)(p.ws + WS_Q);
    const float* sinks = p.in[16];
    const int nitems = (M / 64) * 4;
    for (int i = blockIdx.x; i < nitems; i += gridDim.x) {
        const int kvh = i & 3, ch = i >> 2;
        const int rowc = ch * 64, row0 = rowc + 32 * (wave >> 2);
        const int head = kvh * 4 + (wave & 3);
        const float sink2 = sinks[head] * LOG2E;
        const bf16_t* Kb; const bf16_t* Vb; int ldv, kt_hi, kt_lo;
        if (rowc < MP) {
            const int b = rowc >> 14, t = rowc & (S - 1), c = t >> 6;
            Kb = (const bf16_t*)(p.ws + WS_K1P) + (size_t)b * S * 256 + kvh * 64;
            Vb = (const bf16_t*)(p.ws + WS_VT1P) + (size_t)(b * 4 + kvh) * 64 * S; ldv = S;
            kt_hi = c; kt_lo = c >= 2 ? c - 2 : 0;
        } else {
            const int b = (rowc - MP) >> 6;
            Kb = (const bf16_t*)(p.ws + WS_K1S) + (size_t)b * 192 * 256 + kvh * 64;
            Vb = (const bf16_t*)(p.ws + WS_VT1S) + (size_t)(b * 4 + kvh) * 64 * 192; ldv = 192;
            kt_hi = 2; kt_lo = 0;
        }
        attn_item<2>(Q + (size_t)row0 * 1024 + head * 64, Q + (size_t)row0 * 1024 + head * 64, 0, true, Kb, 256, Vb, ldv, nullptr, kt_hi, kt_lo, sink2, 0.f, lds);
    }
}

DI void phase_final(const Params& p) {
    const int lane = threadIdx.x & 63, wave = threadIdx.x >> 6;
    const float* ssq = (const float*)(p.ws + WS_SSQ) + (size_t)6 * M;
    const float* g = p.in[25];
    f32x4 gv[4];
#pragma unroll
    for (int j = 0; j < 4; ++j) gv[j] = *(const f32x4*)(g + 256 * j + 4 * lane);
    for (int row = blockIdx.x * NW + wave; row < M; row += gridDim.x * NW) {
        const float rs = rstd_of(ssq, row);
        float* y = p.out + (size_t)row * D;
#pragma unroll
        for (int j = 0; j < 4; ++j) { f32x4 v = *(f32x4*)(y + 256 * j + 4 * lane); v = v * rs * gv[j]; *(f32x4*)(y + 256 * j + 4 * lane) = v; }
    }
}

#define LAS __attribute__((address_space(3)))
#define XB_TMO      128
#define XB_XCNT(j)  (256  + 64 * (j))
#define XB_XSUB(j)  (1280 + 64 * (j))
#define XB_XGEN(j)  (2304 + 64 * (j))
#define XB_TOP      3328
#define XB_TOPGEN   3392
#define XCD_BAR_WORDS 3456
#define XB_SPIN_CAP (1u << 18)

__device__ __forceinline__ unsigned xb_ld(unsigned* p)              { return __hip_atomic_load(p, __ATOMIC_RELAXED, __HIP_MEMORY_SCOPE_AGENT); }
__device__ __forceinline__ unsigned xb_add(unsigned* p, unsigned v) { return __hip_atomic_fetch_add(p, v, __ATOMIC_RELAXED, __HIP_MEMORY_SCOPE_AGENT); }
__device__ __forceinline__ unsigned xb_xcc_id() { return (unsigned)__builtin_amdgcn_s_getreg((3 << 11) | 20) & 0xFu; }
#define XB_SPIN(cond, bar) do { unsigned _sp = 0; while (cond) { __builtin_amdgcn_s_sleep(1); \
    if ((++_sp & 255u) == 0u) { if (xb_ld(&(bar)[XB_TMO])) break; if (_sp > XB_SPIN_CAP) { atomicAdd(&(bar)[XB_TMO], 1u); break; } } } } while (0)

struct XcdBarrier {
    unsigned* bar; unsigned x;
    volatile LAS unsigned* st;
};

__device__ __forceinline__ XcdBarrier xcd_barrier_post(unsigned* bar, volatile LAS unsigned* st) {
    XcdBarrier b; b.bar = bar; b.x = xb_xcc_id(); b.st = st;
    if (threadIdx.x == 0) (void)xb_add(&bar[XB_XCNT(b.x)], 1u);
    return b;
}
__device__ __forceinline__ void xcd_barrier_complete(unsigned* bar, unsigned x, unsigned& nloc, unsigned& nx) {
    const unsigned G = gridDim.x * gridDim.y * gridDim.z;
    unsigned sum, cnt, mine, sp = 0u;
    for (;;) {
        sum = 0u; cnt = 0u; mine = 0u;
#pragma unroll
        for (unsigned j = 0; j < 16; ++j) { const unsigned c = xb_ld(&bar[XB_XCNT(j)]); sum += c; cnt += (c > 0u) ? 1u : 0u; mine = (j == x) ? c : mine; }
        if (sum == G) break;
        __builtin_amdgcn_s_sleep(1);
        if ((++sp & 255u) == 0u) { if (xb_ld(&bar[XB_TMO])) break; if (sp > XB_SPIN_CAP) { atomicAdd(&bar[XB_TMO], 1u); break; } }
    }
    nloc = mine > 0u ? mine : 1u; nx = cnt > 0u ? cnt : 1u;
}

__device__ __forceinline__ void xcd_barrier(const XcdBarrier& b) {
    asm volatile("s_waitcnt vmcnt(0)" ::: "memory");
    __syncthreads();
    if (threadIdx.x == 0) {
        unsigned* bar = b.bar;
        __builtin_amdgcn_s_waitcnt(0);
        unsigned nloc = b.st[0], nx = b.st[1];
        if (nloc == 0u) { xcd_barrier_complete(bar, b.x, nloc, nx); b.st[0] = nloc; b.st[1] = nx; }
        const unsigned old = xb_add(&bar[XB_XSUB(b.x)], 1u);
        const unsigned gen = old / nloc;
        if (old + 1u == (gen + 1u) * nloc) {
            __builtin_amdgcn_fence(__ATOMIC_RELEASE, "agent");
            asm volatile("s_waitcnt vmcnt(0)" ::: "memory");
            const unsigned og = xb_add(&bar[XB_TOP], 1u);
            const unsigned tg = og / nx;
            if (og + 1u == (tg + 1u) * nx) xb_add(&bar[XB_TOPGEN], 1u);
            else XB_SPIN(xb_ld(&bar[XB_TOPGEN]) == tg, bar);
            __builtin_amdgcn_fence(__ATOMIC_ACQUIRE, "agent");
            xb_add(&bar[XB_XGEN(b.x)], 1u);
            asm volatile("s_waitcnt vmcnt(0)" ::: "memory");
        } else {
            XB_SPIN(xb_ld(&bar[XB_XGEN(b.x)]) == gen, bar);
            __builtin_amdgcn_fence(__ATOMIC_ACQUIRE, "agent");
            asm volatile("s_waitcnt vmcnt(0)" ::: "memory");
        }
    }
    __syncthreads();
}


__global__ void __launch_bounds__(NTHR, 2) trunk_fwd(Params p) {
    __shared__ __attribute__((aligned(16))) char lds[LDS_BYTES];
    __shared__ __attribute__((aligned(16))) unsigned bar_st[4];
    if (threadIdx.x < 4) bar_st[threadIdx.x] = 0u;
    __syncthreads();
    const XcdBarrier gbar = xcd_barrier_post((unsigned*)(p.ws + WS_BAR), (volatile LAS unsigned*)bar_st);
#define PHASE(k, ...) if (p.ph_lo <= (k) && (k) < p.ph_hi) { __VA_ARGS__; if ((k) + 1 < p.ph_hi) { if ((k) == 0) cg::this_grid().sync(); else xcd_barrier(gbar); } }
    PHASE(0, phase_prep(p, lds))
    int cfirst = blockIdx.x, kfirst = (int)gridDim.x - 1 - (int)blockIdx.x, cstride = gridDim.x;
    if (gridDim.x == 256) { const int local = blockIdx.x >> 3, s = (blockIdx.x & 7) * 24 + (local - 8); cstride = 192; cfirst = local >= 8 ? s : 1 << 20; kfirst = local >= 8 ? 191 - s : 1 << 20; }
    PHASE(1, gemm_phase<E_INPROJ0, 3>(p, 0, lds); cumsum_items(p, lds, cfirst, cstride); kmax_items(p, lds, kfirst, cstride))
    PHASE(2, phase_attn0(p, lds))
    PHASE(3, gemm_phase<E_OUT, 3>(p, 0, lds))
    PHASE(4, gemm_phase<E_GU, 4>(p, 0, lds))
    PHASE(5, gemm_phase<E_DOWN, 3>(p, 0, lds))
    PHASE(6, gemm_phase<E_PE, 2>(p, 0, lds))
    PHASE(7, gemm_phase<E_INPROJ1, 3>(p, 1, lds))
    PHASE(8, phase_attn1(p, lds))
    PHASE(9, gemm_phase<E_OUT, 3>(p, 1, lds))
    PHASE(10, gemm_phase<E_GU, 4>(p, 1, lds))
    PHASE(11, gemm_phase<E_DOWN, 3>(p, 1, lds))
    PHASE(12, gemm_phase<E_PE, 2>(p, 1, lds))
    PHASE(13, phase_final(p))
#undef PHASE
}

extern "C" void kernel_launch(void* const* d_in, const int* in_sizes, int n_in, void* d_out, int out_size, void* d_ws, size_t ws_size, hipStream_t stream) {
    static int grid = 0;
    if (grid == 0) {
        if (n_in != 26 || (size_t)out_size != O_END || ws_size < WS_END) {
            fprintf(stderr, "kernel_launch: unexpected shapes: n_in %d out %d (want %zu) ws %zu (need %zu)\n", n_in, out_size, (size_t)O_END, ws_size, (size_t)WS_END);
            grid = -1; return;
        }
        int dev = 0, cus = 0, per_cu = 0;
        hipGetDevice(&dev);
        hipDeviceGetAttribute(&cus, hipDeviceAttributeMultiprocessorCount, dev);
        hipOccupancyMaxActiveBlocksPerMultiprocessor(&per_cu, (const void*)trunk_fwd, NTHR, 0);
        if (per_cu < 1) per_cu = 1;
        if (per_cu > 1) per_cu = 1;
        grid = cus * per_cu;
    }
    if (grid < 0) return;
    Params p{};
    for (int i = 0; i < 26; ++i) p.in[i] = (const float*)d_in[i];
    p.out = (float*)d_out; p.ws = (unsigned char*)d_ws;
    (void)hipMemsetAsync((unsigned char*)d_ws + WS_KMAX, 0, 1024 + 16384, stream);
#if MULTI_LAUNCH
    for (int ph = 0; ph < 14; ++ph) { p.ph_lo = ph; p.ph_hi = ph + 1; hipLaunchKernelGGL(trunk_fwd, dim3(grid), dim3(NTHR), 0, stream, p); }
#else
    p.ph_lo = 0; p.ph_hi = 14;
    void* args[] = {&p};
    hipError_t e = hipLaunchCooperativeKernel((const void*)trunk_fwd, dim3(grid), dim3(NTHR), args, 0, stream);
    if (e != hipSuccess) fprintf(stderr, "cooperative launch failed: %s (grid %d)\n", hipGetErrorString(e), grid);
#endif
}
```
